# Optimizing an MI355X kernel written in HIP

```python
import math
import jax, jax.numpy as jnp
from jax import lax
import numpy as np

D_MODEL = 1024
BATCH = 4
SEQ = 8192
DEPTH = 2
DEC_BATCH = 32
DEC_SEQ = 16
PAST_LEN = 1024

CHUNK = 64
MIX_WIDTH = D_MODEL
HG_WIDTH = MIX_WIDTH // 2
HG_HEAD_DIM = 128
HG_HEADS = HG_WIDTH // HG_HEAD_DIM
ATT_WIDTH = MIX_WIDTH - HG_WIDTH
ATT_HEAD_DIM = 64
ATT_HEADS = ATT_WIDTH // ATT_HEAD_DIM
LEFT_CHUNKS = 8
ATT_REACH = LEFT_CHUNKS * CHUNK
BAND = ATT_REACH + CHUNK
REL_CLIP = 128
N_REL = 2 * REL_CLIP + 1
D_FF = 4 * D_MODEL
IN_WIDTH = 4 * HG_WIDTH + 3 * ATT_WIDTH
SPLITS = [HG_WIDTH, 2 * HG_WIDTH, 3 * HG_WIDTH, 4 * HG_WIDTH,
          4 * HG_WIDTH + ATT_WIDTH, 4 * HG_WIDTH + 2 * ATT_WIDTH]
EPS = 1e-6
NEG = -1e30

kernel_name = 'hymba_hgrn2_chunkband_stream_step'


def rmsnorm(x, g):
    xf = x.astype(jnp.float32)
    y = xf * lax.rsqrt(jnp.mean(xf * xf, axis=-1, keepdims=True) + EPS)
    return (y * g.astype(jnp.float32)).astype(x.dtype)


def hgrn2_scan(q, k, v, logf, s0):
    B, T, H, DK = q.shape
    C = min(CHUNK, T)
    N = T // C

    def to_chunks(a):
        return a.reshape(B, N, C, H, a.shape[-1]).transpose(1, 0, 3, 2, 4)

    qc, kc, vc, gc = to_chunks(q), to_chunks(k), to_chunks(v), to_chunks(logf)
    causal = jnp.tril(jnp.ones((C, C), dtype=bool))[:, :, None]

    def step(S, inp):
        qb, kb, vb, gb = inp
        b = jnp.cumsum(gb, axis=2)
        inter = jnp.einsum('bhtk,bhkv->bhtv', qb * jnp.exp(b), S)
        diff = b[:, :, :, None, :] - b[:, :, None, :, :]
        decay = jnp.where(causal, jnp.exp(jnp.minimum(diff, 0.0)), 0.0)
        scores = jnp.einsum('bhtsk,bhsk->bhts', qb[:, :, :, None, :] * decay, kb)
        intra = jnp.einsum('bhts,bhsv->bhtv', scores, vb)
        b_last = b[:, :, -1:, :]
        S_new = (jnp.exp(b_last[:, :, 0, :])[..., None] * S
                 + jnp.einsum('bhsk,bhsv->bhkv', kb * jnp.exp(b_last - b), vb))
        return S_new, inter + intra

    S_fin, o = lax.scan(step, s0, (qc, kc, vc, gc))
    o = o.transpose(1, 0, 3, 2, 4).reshape(B, T, H, v.shape[-1])
    return o, S_fin


def band_attention(q, k, v, qpos, kpos, kvalid, rel_bias):
    rel = jnp.clip(kpos[None, :] - qpos[:, None], -REL_CLIP, REL_CLIP) + REL_CLIP
    bias = rel_bias.astype(jnp.float32)[:, rel]
    s = jnp.einsum('bqhd,bkhd->bhqk', q, k, preferred_element_type=jnp.float32)
    s = s * (1.0 / math.sqrt(ATT_HEAD_DIM)) + bias[None]
    s = jnp.where(kvalid[None, None, None, :], s, NEG)
    p = jax.nn.softmax(s, axis=-1)
    return jnp.einsum('bhqk,bkhd->bqhd', p.astype(v.dtype), v)


def prompt_attention(q, k, v, rel_bias):
    B, T, H, Dh = q.shape
    N = T // CHUNK
    pad = ((0, 0), (ATT_REACH, 0), (0, 0), (0, 0))
    kp = jnp.pad(k, pad)
    vp = jnp.pad(v, pad)
    qc = q.reshape(B, N, CHUNK, H, Dh).transpose(1, 0, 2, 3, 4)
    key_off = jnp.arange(BAND) - ATT_REACH
    q_off = jnp.arange(CHUNK)

    def one_chunk(args):
        c, qb = args
        start = c * CHUNK
        kb = lax.dynamic_slice_in_dim(kp, start, BAND, axis=1)
        vb = lax.dynamic_slice_in_dim(vp, start, BAND, axis=1)
        kpos = start + key_off
        return band_attention(qb, kb, vb, start + q_off, kpos, kpos >= 0, rel_bias)

    o = lax.map(one_chunk, (jnp.arange(N), qc))
    return o.transpose(1, 0, 2, 3, 4).reshape(B, T, H, Dh)


def trunk_layer(x, s0, k_past, v_past, lb, norm1_g, w_in, hg_norm_g, rel_bias,
                att_norm_g, w_out, norm2_g, w_up, w_down):
    B, T, _ = x.shape
    f32 = jnp.float32
    h = rmsnorm(x, norm1_g)
    proj = h @ w_in
    hq, hf, hi, hg, aq, ak, av = jnp.split(proj, SPLITS, axis=-1)

    fgate = lb + (1.0 - lb) * jax.nn.sigmoid(hf.astype(f32))
    logf = jnp.log(fgate)
    kk = 1.0 - fgate
    hd = lambda a: a.reshape(B, T, HG_HEADS, HG_HEAD_DIM)
    if s0 is None:
        s0 = jnp.zeros((B, HG_HEADS, HG_HEAD_DIM, HG_HEAD_DIM), f32)
    o_h, s_new = hgrn2_scan(hd(hq.astype(f32)), hd(kk), hd(hi.astype(f32)), hd(logf), s0.astype(f32))
    o_h = rmsnorm(o_h, hg_norm_g.reshape(HG_HEADS, HG_HEAD_DIM)).reshape(B, T, HG_WIDTH)
    o_h = (o_h * jax.nn.silu(hg.astype(f32))).astype(x.dtype)

    ad = lambda a: a.reshape(B, T, ATT_HEADS, ATT_HEAD_DIM)
    q, k, v = ad(aq), ad(ak), ad(av)
    if k_past is None:
        o_a = prompt_attention(q, k, v, rel_bias)
        keep = min(ATT_REACH, T)
        k_rows, v_rows = k[:, T - keep:], v[:, T - keep:]
    else:
        W = k_past.shape[1]
        k_all = jnp.concatenate([k_past.astype(k.dtype), k], axis=1)
        v_all = jnp.concatenate([v_past.astype(v.dtype), v], axis=1)
        kpos = jnp.arange(W + T) - W
        o_a = band_attention(q, k_all, v_all, jnp.arange(T), kpos,
                             jnp.ones((W + T,), dtype=bool), rel_bias)
        k_rows, v_rows = k, v
    o_a = rmsnorm(o_a.reshape(B, T, ATT_WIDTH), att_norm_g)

    x = x + jnp.concatenate([o_h, o_a.astype(x.dtype)], axis=-1) @ w_out
    u = rmsnorm(x, norm2_g) @ w_up
    x = x + jnp.square(jax.nn.relu(u)) @ w_down
    return x, s_new, k_rows, v_rows


def setup_inputs(seed: int = 0) -> dict:
    key = jax.random.key(seed)
    ks = jax.random.split(key, 16)
    n = lambda k, shape, s: (jax.random.normal(k, shape, jnp.float32) * s)
    att_cache_len = min(ATT_REACH, PAST_LEN)
    return {
        'x_prompt': n(ks[0], (BATCH, SEQ, D_MODEL), 1.0),
        'x_sample': n(ks[1], (DEC_BATCH, DEC_SEQ, D_MODEL), 1.0),
        'state_hgrn': n(ks[2], (DEPTH, DEC_BATCH, HG_HEADS, HG_HEAD_DIM, HG_HEAD_DIM), 0.5),
        'cache_k': n(ks[3], (DEPTH, DEC_BATCH, att_cache_len, ATT_HEADS, ATT_HEAD_DIM), 1.0),
        'cache_v': n(ks[4], (DEPTH, DEC_BATCH, att_cache_len, ATT_HEADS, ATT_HEAD_DIM), 1.0),
        'lb_param': n(ks[5], (DEPTH, HG_WIDTH), 0.5),
        'norm1_g': 1.0 + n(ks[6], (DEPTH, D_MODEL), 0.1),
        'w_in': n(ks[7], (DEPTH, D_MODEL, IN_WIDTH), D_MODEL ** -0.5),
        'hg_norm_g': 1.0 + n(ks[8], (DEPTH, HG_WIDTH), 0.1),
        'rel_bias': n(ks[9], (DEPTH, ATT_HEADS, N_REL), 0.5),
        'att_norm_g': 1.0 + n(ks[10], (DEPTH, ATT_WIDTH), 0.1),
        'w_out': n(ks[11], (DEPTH, MIX_WIDTH, D_MODEL), MIX_WIDTH ** -0.5),
        'norm2_g': 1.0 + n(ks[12], (DEPTH, D_MODEL), 0.1),
        'w_up': n(ks[13], (DEPTH, D_MODEL, D_FF), D_MODEL ** -0.5),
        'w_down': n(ks[14], (DEPTH, D_FF, D_MODEL), 0.5 * D_FF ** -0.5),
        'final_norm_g': 1.0 + n(ks[15], (D_MODEL,), 0.1),
    }


def reference(x_prompt, x_sample, state_hgrn, cache_k, cache_v, lb_param, norm1_g, w_in,
              hg_norm_g, rel_bias, att_norm_g, w_out, norm2_g, w_up, w_down, final_norm_g):
    sm = jax.nn.softmax(lb_param.astype(jnp.float32), axis=0)
    lbs = jnp.cumsum(sm, axis=0) - sm[0:1]
    xp, xs = x_prompt, x_sample
    sp_l, kp_l, vp_l, ss_l, ks_l, vs_l = [], [], [], [], [], []
    for l in range(DEPTH):
        lw = (lbs[l], norm1_g[l], w_in[l], hg_norm_g[l], rel_bias[l], att_norm_g[l],
              w_out[l], norm2_g[l], w_up[l], w_down[l])
        xp, sp, kp, vp = trunk_layer(xp, None, None, None, *lw)
        xs, ss, ksm, vsm = trunk_layer(xs, state_hgrn[l], cache_k[l], cache_v[l], *lw)
        sp_l.append(sp); kp_l.append(kp); vp_l.append(vp)
        ss_l.append(ss); ks_l.append(ksm); vs_l.append(vsm)
    y_prompt = rmsnorm(xp, final_norm_g)
    y_sample = rmsnorm(xs, final_norm_g)
    new_state_hgrn_prompt = jnp.stack(sp_l)
    new_cache_k_prompt = jnp.stack(kp_l)
    new_cache_v_prompt = jnp.stack(vp_l)
    new_state_hgrn_sample = jnp.stack(ss_l)
    new_cache_k_sample = jnp.stack(ks_l)
    new_cache_v_sample = jnp.stack(vs_l)
    return (y_prompt, y_sample, new_state_hgrn_prompt, new_cache_k_prompt, new_cache_v_prompt,
            new_state_hgrn_sample, new_cache_k_sample, new_cache_v_sample)
```

```cpp
#include <hip/hip_runtime.h>
#include <hip/hip_cooperative_groups.h>
#include <cstdio>
namespace cg = cooperative_groups;
namespace pg8 {
#define PG8_LAS __attribute__((address_space(3)))
typedef unsigned short bf16_t;
typedef short bf16x8 __attribute__((ext_vector_type(8)));
typedef float f32x4 __attribute__((ext_vector_type(4)));
typedef unsigned u32x4 __attribute__((ext_vector_type(4)));
constexpr int BM = 256, BK = 64, HALF = 128, HTB = HALF * BK * 2  , STAGE_BYTES = 8 * HTB, NXCD = 8, WGM = 8;

__host__ __device__ __forceinline__ int lds_byte(int r, int c) { const int st = (r >> 4) * 2 + (c >> 5), rr = r & 15, cc = c & 31, ob = rr * 64 + cc * 2; return st * 1024 + (ob ^ (((ob >> 9) & 1) << 5)); }
__host__ __device__ __forceinline__ void stage_rc(int b, int& R, int& C) { const int st = b / 1024, sb = b % 1024, swz = sb ^ (((sb >> 9) & 1) << 5); R = (st >> 1) * 16 + swz / 64; C = (st & 1) * 32 + (swz % 64) / 2; }
__host__ __device__ __forceinline__ int perm32(int rho) { const int n = rho >> 4, i = rho & 15; return 8 * (i >> 2) + 4 * n + (i & 3); }

struct Unit { int pm, pn; };
struct Gemm { const bf16_t* A; const bf16_t* Bt; int M, N, K; };

struct StaticOrder {
    int nM, nN, nwg, G, c;
    __host__ __device__ void init(int M, int N, int G_, int c_) { nM = M / BM; nN = N / BM; nwg = nM * nN; G = G_; c = c_; }
    __host__ __device__ bool next(int i, Unit& u) const {
        const long L = (long)i * G + c; if (L >= nwg) return false;
        int wgid = (int)L; { const int q = nwg / NXCD, r = nwg % NXCD, xcd = wgid % NXCD, off = wgid / NXCD; wgid = (xcd < r ? xcd * (q + 1) : r * (q + 1) + (xcd - r) * q) + off; }
        const int nig = WGM * nN, gid = wgid / nig, fm = gid * WGM, gsz = (nM - fm) < WGM ? (nM - fm) : WGM;
        u.pm = fm + ((wgid % nig) % gsz); u.pn = (wgid % nig) / gsz; return true;
    }
    __device__ __forceinline__ void a_ready(const Unit&) const {}
    __device__ __forceinline__ void done(const Unit&) const {}
};
__device__ __forceinline__ unsigned cvt_pk_bf16(float lo, float hi) { unsigned r; asm volatile("v_cvt_pk_bf16_f32 %0, %1, %2" : "=v"(r) : "v"(lo), "v"(hi)); return r; }

template <class Epi, class Sched, bool STAMP = false>
__device__ __forceinline__ void gemm_phase(PG8_LAS unsigned char* lds, const Gemm g, const Sched& S, const Epi& E, unsigned long long* stamps) {
    int tid_l = threadIdx.x; asm volatile("" : "+v"(tid_l)); const int tid = tid_l, wid = __builtin_amdgcn_readfirstlane(tid >> 6), lane = tid & 63, wr = wid >> 2, wc = wid & 3, fr = lane & 15, fq = lane >> 4;
    const int K = g.K, nt = K / BK;
    int ts_lo = 0, ts_hi = 0, nts = 0; const unsigned long long rt_entry = STAMP ? (unsigned long long)wall_clock64() : 0ull;
#define PG8_STAMP() do { if (STAMP && wid == 0 && nts < 64) { const unsigned long long _c = (unsigned long long)clock64(); \
        ts_lo = (lane == nts) ? (int)(unsigned)_c : ts_lo; ts_hi = (lane == nts) ? (int)(unsigned)(_c >> 32) : ts_hi; ++nts; } } while (0)
    PG8_STAMP();
    unsigned voffA[2], voffB[2];
#pragma unroll
    for (int i = 0; i < 2; ++i) { int R, C; stage_rc(tid * 16 + i * 8192, R, C); const int Rb = Epi::PERM ? ((R & ~31) + perm32(R & 31)) : R;
        voffA[i] = (unsigned)(R * K + C) * 2u; voffB[i] = (unsigned)(Rb * K + C) * 2u; }
    const size_t kstep = (size_t)(BK * 2);
    const size_t hstep = (size_t)HALF * K * 2;
    const size_t tstep = 2 * hstep;
    const unsigned ldsw = (unsigned)wid * 1024u;
    const int aoff = lds_byte(wr * 64 + fr, fq * 8), boff = lds_byte(wc * 32 + fr, fq * 8);
#define PG8_SA(b, h) (((b) * 2 + (h)) * HTB)
#define PG8_SB(b, h) ((4 + (b) * 2 + (h)) * HTB)
#define PG8_STAGE(bufoff, gbase, voff) do { _Pragma("unroll") for (int _i = 0; _i < 2; ++_i) \
        __builtin_amdgcn_global_load_lds((const unsigned*)((const char*)(gbase) + (voff)[_i]), (PG8_LAS unsigned*)(lds + (bufoff) + ldsw + _i * 8192), 16, 0, 0); } while (0)
#define PG8_LDA(dst, b, h) do { _Pragma("unroll") for (int m = 0; m < 4; ++m) _Pragma("unroll") for (int k = 0; k < 2; ++k) dst[m][k] = *(const PG8_LAS bf16x8*)(lds + PG8_SA(b, h) + aoff + m * 2048 + k * 1024); } while (0)
#define PG8_LDB(dst, b, h) do { _Pragma("unroll") for (int n = 0; n < 2; ++n) _Pragma("unroll") for (int k = 0; k < 2; ++k) dst[n][k] = *(const PG8_LAS bf16x8*)(lds + PG8_SB(b, h) + boff + n * 2048 + k * 1024); } while (0)
#define PG8_MMA(ai, bj, At, Bt) do { __builtin_amdgcn_s_setprio(1); _Pragma("unroll") for (int m = 0; m < 4; ++m) _Pragma("unroll") for (int n = 0; n < 2; ++n) _Pragma("unroll") for (int k = 0; k < 2; ++k) \
        acc[ai][bj][m][n] = __builtin_amdgcn_mfma_f32_16x16x32_bf16(Bt[n][k], At[m][k], acc[ai][bj][m][n], 0, 0, 0); __builtin_amdgcn_s_setprio(0); } while (0)
#define PG8_WAIT_V(n) asm volatile("s_waitcnt vmcnt(" #n ")" ::: "memory")
#define PG8_WAIT_L(n) asm volatile("s_waitcnt lgkmcnt(" #n ")" ::: "memory")
#define PG8_BAR __builtin_amdgcn_s_barrier()
#define PG8_SCHED __builtin_amdgcn_sched_barrier(0)
    Unit cur, nxt; int ui = 0;
    if (!S.next(0, cur)) return;
    f32x4 acc[2][2][4][2];
#pragma unroll
    for (int a = 0; a < 2; ++a)
#pragma unroll
        for (int b = 0; b < 2; ++b)
#pragma unroll
            for (int m = 0; m < 4; ++m)
#pragma unroll
                for (int n = 0; n < 2; ++n) acc[a][b][m][n] = (f32x4){0.f, 0.f, 0.f, 0.f};
    bf16x8 At[4][2], B0[2][2], B1[2][2];
    const char* cA = (const char*)g.A + (size_t)cur.pm * tstep; const char* cB = (const char*)g.Bt + (size_t)cur.pn * tstep;
    S.a_ready(cur);
    PG8_STAGE(PG8_SB(0, 0), cB, voffB); PG8_STAGE(PG8_SA(0, 0), cA, voffA); PG8_STAGE(PG8_SB(0, 1), cB + hstep, voffB); PG8_STAGE(PG8_SA(0, 1), cA + hstep, voffA);
    if (wr == 1) PG8_BAR;
    PG8_WAIT_V(4); PG8_BAR;
    PG8_STAGE(PG8_SB(1, 0), cB + kstep, voffB); PG8_STAGE(PG8_SA(1, 0), cA + kstep, voffA); PG8_STAGE(PG8_SB(1, 1), cB + hstep + kstep, voffB);
    PG8_WAIT_V(6); PG8_BAR;
    PG8_STAMP();
    for (;;) {
        const bool has_next = S.next(ui + 1, nxt);
        const char* nA = has_next ? (const char*)g.A + (size_t)nxt.pm * tstep : cA; const char* nB = has_next ? (const char*)g.Bt + (size_t)nxt.pn * tstep : cB;
        for (int t = 0; t < nt; t += 2) {
            const bool last = (t == nt - 2);
            const char* a1 = cA + (size_t)(t + 1) * kstep;
            const char* a2 = last ? nA : cA + (size_t)(t + 2) * kstep; const char* b2 = last ? nB : cB + (size_t)(t + 2) * kstep;
            const char* a3 = a2 + kstep; const char* b3 = b2 + kstep;
            if (last && has_next) S.a_ready(nxt);
            PG8_LDB(B0, 0, 0); PG8_SCHED; PG8_LDA(At, 0, 0); PG8_STAGE(PG8_SA(1, 1), a1 + hstep, voffA);
            PG8_WAIT_L(8); PG8_BAR; PG8_WAIT_L(0); PG8_MMA(0, 0, At, B0); PG8_BAR; PG8_SCHED;
            PG8_LDB(B1, 0, 1); PG8_STAGE(PG8_SB(0, 0), b2, voffB);
            PG8_BAR; PG8_WAIT_L(0); PG8_MMA(0, 1, At, B1); PG8_BAR;
            PG8_LDA(At, 0, 1); PG8_STAGE(PG8_SA(0, 0), a2, voffA);
            PG8_BAR; PG8_WAIT_L(0); PG8_MMA(1, 0, At, B0); PG8_BAR; PG8_SCHED;
            PG8_STAGE(PG8_SB(0, 1), b2 + hstep, voffB);
            PG8_WAIT_V(6); PG8_BAR; PG8_MMA(1, 1, At, B1); PG8_BAR;
            PG8_LDB(B0, 1, 0); PG8_SCHED; PG8_LDA(At, 1, 0); PG8_STAGE(PG8_SA(0, 1), a2 + hstep, voffA);
            PG8_WAIT_L(8); PG8_BAR; PG8_WAIT_L(0); PG8_MMA(0, 0, At, B0); PG8_BAR; PG8_SCHED;
            PG8_LDB(B1, 1, 1); PG8_STAGE(PG8_SB(1, 0), b3, voffB);
            PG8_BAR; PG8_WAIT_L(0); PG8_MMA(0, 1, At, B1); PG8_BAR;
            PG8_LDA(At, 1, 1); PG8_STAGE(PG8_SA(1, 0), a3, voffA);
            PG8_BAR; PG8_WAIT_L(0); PG8_MMA(1, 0, At, B0); PG8_BAR; PG8_SCHED;
            PG8_STAGE(PG8_SB(1, 1), b3 + hstep, voffB);
            PG8_WAIT_V(6); PG8_BAR; PG8_MMA(1, 1, At, B1); PG8_BAR;
        }
        PG8_STAMP();
        if constexpr (!Epi::AFTER_DRAIN) { E(acc, cur, wr, wc, fr, fq); S.done(cur); }
        PG8_STAMP();
        if (!has_next) break;
#pragma unroll
        for (int a = 0; a < 2; ++a)
#pragma unroll
            for (int b = 0; b < 2; ++b)
#pragma unroll
                for (int m = 0; m < 4; ++m)
#pragma unroll
                    for (int n = 0; n < 2; ++n) acc[a][b][m][n] = (f32x4){0.f, 0.f, 0.f, 0.f};
        cur = nxt; cA = nA; cB = nB; ++ui;
    }
    PG8_WAIT_V(0);
    if (wr == 0) PG8_BAR;
    PG8_BAR;
    if constexpr (Epi::AFTER_DRAIN) { E.fused(acc, cur, wr, wc, fr, fq, lds, wid, lane); S.done(cur); }
    PG8_STAMP();
    if (STAMP && wid == 0) { stamps[lane] = lane < nts ? (((unsigned long long)(unsigned)ts_hi << 32) | (unsigned)ts_lo) : 0ull;
        if (lane == 62) stamps[62] = rt_entry; if (lane == 63) stamps[63] = (unsigned long long)wall_clock64(); }
#undef PG8_STAMP
#undef PG8_SA
#undef PG8_SB
#undef PG8_STAGE
#undef PG8_LDA
#undef PG8_LDB
#undef PG8_MMA
#undef PG8_WAIT_V
#undef PG8_WAIT_L
#undef PG8_BAR
#undef PG8_SCHED
}
}

using pg8::bf16_t; using pg8::bf16x8; using pg8::f32x4; using pg8::Unit;
typedef float f32x16 __attribute__((ext_vector_type(16)));
typedef unsigned u32x2 __attribute__((ext_vector_type(2)));
typedef unsigned u32x4v __attribute__((ext_vector_type(4)));

#ifndef MK_ONE_LAUNCH
#define MK_ONE_LAUNCH 1
#endif

constexpr int T_P = 32768, T_S = 512, T_ALL = 33280, DM = 1024, NIN = 3584, DFF = 4096, TPAD = 33344;
constexpr float EPSF = 1e-6f;
constexpr size_t O_Y = 0, O_SP = 34078720, O_KP = 34603008, O_VP = 36700160, O_SS = 38797312, O_KS = 42991616, O_VS = 43515904;
constexpr size_t WS_WIN = 0, WS_WOUT = WS_WIN + 2ull * NIN * DM * 2, WS_WUP = WS_WOUT + 2ull * DM * DM * 2, WS_WDN = WS_WUP + 2ull * DFF * DM * 2,
                 WS_XB = WS_WDN + 2ull * DFF * DM * 2, WS_OB = WS_XB + (size_t)T_ALL * DM * 2, WS_U = WS_OB + (size_t)T_ALL * DM * 2,
                 SZ_P = (size_t)T_ALL * 512 * 2, WS_QH = WS_U, WS_GH = WS_U + SZ_P, WS_QA = WS_U + 2 * SZ_P, WS_KA = WS_U + 3 * SZ_P, WS_LF = WS_U + 4 * SZ_P,
                 WS_VT = WS_LF + (size_t)T_ALL * 512 * 4, WS_ST = WS_VT + (size_t)1024 * TPAD * 2, N_ITEMS = 2176, WS_D = WS_ST + N_ITEMS * 32768ull,
                 WS_SS = WS_D + N_ITEMS * 512ull, WS_BAR = WS_SS + 5ull * T_ALL * 4, WS_END = WS_BAR + 256;
static_assert(WS_VT + (size_t)1024 * TPAD * 2 >= WS_U + (size_t)T_ALL * DFF * 2, "U region");
constexpr int LDS_BYTES = pg8::STAGE_BYTES;

struct Params {
    const float *x_prompt, *x_sample, *state_hgrn, *cache_k, *cache_v, *lb_param, *norm1_g, *w_in, *hg_norm_g, *rel_bias, *att_norm_g, *w_out, *norm2_g, *w_up, *w_down, *final_g;
    float* out; unsigned char* ws; int ph_lo, ph_hi;
};

__device__ __forceinline__ float bf2f(bf16_t b) { return __uint_as_float(((unsigned)b) << 16); }
__device__ __forceinline__ bf16_t f2bf(float f) { unsigned u = __float_as_uint(f); u += 0x7fffu + ((u >> 16) & 1u); return (bf16_t)(u >> 16); }
__device__ __forceinline__ unsigned pk2(float lo, float hi) { return (unsigned)f2bf(lo) | ((unsigned)f2bf(hi) << 16); }
__device__ __forceinline__ bf16x8 pack8(const float* v) {
    u32x4v r; r[0] = pk2(v[0], v[1]); r[1] = pk2(v[2], v[3]); r[2] = pk2(v[4], v[5]); r[3] = pk2(v[6], v[7]);
    return __builtin_bit_cast(bf16x8, r);
}
__device__ __forceinline__ float xor32(float v) { return __shfl_xor(v, 32, 64); }

typedef const Params __attribute__((address_space(4)))* KP;
__device__ __forceinline__ KP kparams() { unsigned long long a = (unsigned long long)__builtin_amdgcn_kernarg_segment_ptr(); asm volatile("" : "+s"(a)); return (KP)a; }
__device__ __forceinline__ Params load_params() { KP kp = kparams(); Params p; p.x_prompt = kp->x_prompt; p.x_sample = kp->x_sample; p.state_hgrn = kp->state_hgrn; p.cache_k = kp->cache_k; p.cache_v = kp->cache_v; p.lb_param = kp->lb_param; p.norm1_g = kp->norm1_g; p.w_in = kp->w_in; p.hg_norm_g = kp->hg_norm_g; p.rel_bias = kp->rel_bias; p.att_norm_g = kp->att_norm_g; p.w_out = kp->w_out; p.norm2_g = kp->norm2_g; p.w_up = kp->w_up; p.w_down = kp->w_down; p.final_g = kp->final_g; p.out = kp->out; p.ws = kp->ws; p.ph_lo = kp->ph_lo; p.ph_hi = kp->ph_hi; return p; }
#ifndef NOTYPE
#define NOTYPE -1
#endif
struct EpiIn {
    static constexpr bool PERM = true, AFTER_DRAIN = false;
    int l;
    template <int TYPE> __device__ __forceinline__ void run(const f32x4 (&acc)[2][2][4][2], const Unit& u, int wr, int wc, int fr, int fq) const {
        const Params P = load_params(); unsigned char* ws = P.ws; const float* ss = (const float*)(ws + WS_SS) + 2 * l * T_ALL; const float* lbp = P.lb_param; float* out = P.out;
        bf16_t* QH = (bf16_t*)(ws + WS_QH); bf16_t* GH = (bf16_t*)(ws + WS_GH); bf16_t* QA = (bf16_t*)(ws + WS_QA); bf16_t* KA = (bf16_t*)(ws + WS_KA); bf16_t* VT = (bf16_t*)(ws + WS_VT); float* LF = (float*)(ws + WS_LF);
        (void)lbp; (void)out; (void)QH; (void)GH; (void)QA; (void)KA; (void)VT; (void)LF;
        const int cbase = (u.pn & 1) * 256 + wc * 32 + 8 * fq;
#pragma unroll
        for (int ai = 0; ai < 2; ++ai)
#pragma unroll
            for (int m = 0; m < 4; ++m) {
                const int row = u.pm * 256 + ai * 128 + wr * 64 + m * 16 + fr;
                const float rstd = rsqrtf(ss[row] * (1.0f / 1024.0f) + EPSF);
#pragma unroll
                for (int bj = 0; bj < 2; ++bj) {
                    const int cb = cbase + bj * 128;
                    float v[8];
#pragma unroll
                    for (int j = 0; j < 4; ++j) { v[j] = acc[ai][bj][m][0][j] * rstd; v[4 + j] = acc[ai][bj][m][1][j] * rstd; }
                    if constexpr (TYPE == 0) { *(bf16x8*)(QH + (size_t)row * 512 + cb) = pack8(v); }
                    else if constexpr (TYPE == 1) {
                        float o[8];
#pragma unroll
                        for (int j = 0; j < 8; ++j) {
                            float lb = 0.f;
                            if (l == 1) { const float p0 = lbp[cb + j], p1 = lbp[512 + cb + j]; lb = 1.0f / (1.0f + __expf(p0 - p1)); }
                            const float sg = 1.0f / (1.0f + __expf(-v[j]));
                            o[j] = __logf(lb + (1.0f - lb) * sg);
                        }
                        float* d = LF + (size_t)row * 512 + cb;
                        *(f32x4*)d = (f32x4){o[0], o[1], o[2], o[3]}; *(f32x4*)(d + 4) = (f32x4){o[4], o[5], o[6], o[7]};
                    }
                    else if constexpr (TYPE == 2 || TYPE == 6) {
                        bf16_t* d = VT + (size_t)((TYPE == 6 ? 512 : 0) + cb) * TPAD + row;
#pragma unroll
                        for (int j = 0; j < 8; ++j) d[(size_t)j * TPAD] = f2bf(v[j]);
                    }
                    else if constexpr (TYPE == 3) {
                        float o[8];
#pragma unroll
                        for (int j = 0; j < 8; ++j) o[j] = v[j] / (1.0f + __expf(-v[j]));
                        *(bf16x8*)(GH + (size_t)row * 512 + cb) = pack8(o);
                    }
                    else if constexpr (TYPE == 4) {
                        float o[8];
#pragma unroll
                        for (int j = 0; j < 8; ++j) o[j] = v[j] * 0.125f;
                        *(bf16x8*)(QA + (size_t)row * 512 + cb) = pack8(o);
                    }
                    if constexpr (TYPE == 5) { *(bf16x8*)(KA + (size_t)row * 512 + cb) = pack8(v); }
                    if constexpr (TYPE == 5 || TYPE == 6) {
                        float* d = nullptr;
                        if (row >= T_P) d = out + (TYPE == 5 ? O_KS : O_VS) + ((size_t)l * 512 + (row - T_P)) * 512 + cb;
                        else { const int t = row & 8191, b = row >> 13; if (t >= 7680) d = out + (TYPE == 5 ? O_KP : O_VP) + (((size_t)l * 4 + b) * 512 + (t - 7680)) * 512 + cb; }
                        if (d) { *(f32x4*)d = (f32x4){v[0], v[1], v[2], v[3]}; *(f32x4*)(d + 4) = (f32x4){v[4], v[5], v[6], v[7]}; }
                    }
                }
            }
    }
    __device__ __forceinline__ void operator()(const f32x4 (&acc)[2][2][4][2], const Unit& u, int wr, int wc, int fr, int fq) const {
        switch (u.pn >> 1) {
            case 0: if (NOTYPE != 0) run<0>(acc, u, wr, wc, fr, fq); break;
            case 1: if (NOTYPE != 1) run<1>(acc, u, wr, wc, fr, fq); break;
            case 2: if (NOTYPE != 2) run<2>(acc, u, wr, wc, fr, fq); break;
            case 3: if (NOTYPE != 3) run<3>(acc, u, wr, wc, fr, fq); break;
            case 4: if (NOTYPE != 4) run<4>(acc, u, wr, wc, fr, fq); break;
            case 5: if (NOTYPE != 5) run<5>(acc, u, wr, wc, fr, fq); break;
            default: if (NOTYPE != 6) run<6>(acc, u, wr, wc, fr, fq); break;
        }
    }
};

template <int MODE> struct EpiRes {
    static constexpr bool PERM = true, AFTER_DRAIN = false;
    int l;
    __device__ __forceinline__ void operator()(const f32x4 (&acc)[2][2][4][2], const Unit& u, int wr, int wc, int fr, int fq) const {
        const Params P = load_params(); unsigned char* ws = P.ws; bf16_t* XB = (bf16_t*)(ws + WS_XB); float* X2 = P.out;
        const float* res_p = l == 0 ? P.x_prompt : P.out; const float* res_s = l == 0 ? P.x_sample : P.out + (size_t)T_P * DM;
        float* ssn = (float*)(ws + WS_SS) + (2 * l + 1 + MODE) * T_ALL; (void)res_p; (void)res_s; (void)X2;
        const int cbase = u.pn * 256 + wc * 32 + 8 * fq;
#pragma unroll
        for (int ai = 0; ai < 2; ++ai)
#pragma unroll
            for (int m = 0; m < 4; ++m) {
                const int row = u.pm * 256 + ai * 128 + wr * 64 + m * 16 + fr;
                float s = 0.f;
#pragma unroll
                for (int bj = 0; bj < 2; ++bj) {
                    const int c = cbase + bj * 128;
                    float x[8];
                    if constexpr (MODE == 0) {
                        const float* rp = (row >= T_P) ? res_s + (size_t)(row - T_P) * DM + c : res_p + (size_t)row * DM + c;
                        const f32x4 r0 = *(const f32x4*)rp, r1 = *(const f32x4*)(rp + 4);
#pragma unroll
                        for (int j = 0; j < 4; ++j) { x[j] = r0[j] + acc[ai][bj][m][0][j]; x[4 + j] = r1[j] + acc[ai][bj][m][1][j]; }
                    } else {
                        const u32x4v rb = *(const u32x4v*)(XB + (size_t)row * DM + c);
#pragma unroll
                        for (int j = 0; j < 4; ++j) {
                            x[2 * j] = __uint_as_float(rb[j] << 16) + (j < 2 ? acc[ai][bj][m][0][2 * j] : acc[ai][bj][m][1][2 * j - 4]);
                            x[2 * j + 1] = __uint_as_float(rb[j] & 0xffff0000u) + (j < 2 ? acc[ai][bj][m][0][2 * j + 1] : acc[ai][bj][m][1][2 * j - 3]);
                        }
                        float* d = X2 + (size_t)row * DM + c;
                        *(f32x4*)d = (f32x4){x[0], x[1], x[2], x[3]}; *(f32x4*)(d + 4) = (f32x4){x[4], x[5], x[6], x[7]};
                    }
#pragma unroll
                    for (int j = 0; j < 8; ++j) s += x[j] * x[j];
                    *(bf16x8*)(XB + (size_t)row * DM + c) = pack8(x);
                }
                s += __shfl_xor(s, 16, 64); s += __shfl_xor(s, 32, 64);
                if (fq == 0) atomicAdd(ssn + row, s);
            }
    }
};

struct EpiUp {
    static constexpr bool PERM = true, AFTER_DRAIN = false;
    int l;
    __device__ __forceinline__ void operator()(const f32x4 (&acc)[2][2][4][2], const Unit& u, int wr, int wc, int fr, int fq) const {
        const Params P = load_params(); unsigned char* ws = P.ws; const float* ss = (const float*)(ws + WS_SS) + (2 * l + 1) * T_ALL; bf16_t* U = (bf16_t*)(ws + WS_U);
        const int cbase = u.pn * 256 + wc * 32 + 8 * fq;
#pragma unroll
        for (int ai = 0; ai < 2; ++ai)
#pragma unroll
            for (int m = 0; m < 4; ++m) {
                const int row = u.pm * 256 + ai * 128 + wr * 64 + m * 16 + fr;
                const float rstd = rsqrtf(ss[row] * (1.0f / 1024.0f) + EPSF);
#pragma unroll
                for (int bj = 0; bj < 2; ++bj) {
                    float v[8];
#pragma unroll
                    for (int j = 0; j < 4; ++j) {
                        float a = fmaxf(acc[ai][bj][m][0][j] * rstd, 0.f), b = fmaxf(acc[ai][bj][m][1][j] * rstd, 0.f);
                        v[j] = a * a; v[4 + j] = b * b;
                    }
                    *(bf16x8*)(U + (size_t)row * DFF + cbase + bj * 128) = pack8(v);
                }
            }
    }
};

__device__ void wt_tile(const float* W, int K, int N, const float* g, bf16_t* WT, int kt, int nt, unsigned char* lds) {
    float* tile = (float*)lds;
    int tid_l = threadIdx.x; asm volatile("" : "+v"(tid_l)); const int tid = tid_l, k0 = kt * 64, n0 = nt * 64;
#pragma unroll
    for (int i = 0; i < 2; ++i) {
        const int idx = tid + 512 * i, k = idx >> 4, n4 = (idx & 15) * 4;
        f32x4 v = *(const f32x4*)(W + (size_t)(k0 + k) * N + n0 + n4);
        const float sc = g ? g[k0 + k] : 1.0f;
#pragma unroll
        for (int j = 0; j < 4; ++j) tile[k * 65 + n4 + j] = v[j] * sc;
    }
    __syncthreads();
    {
        const int n = tid >> 3, k8 = (tid & 7) * 8;
        float v[8];
#pragma unroll
        for (int j = 0; j < 8; ++j) v[j] = tile[(k8 + j) * 65 + n];
        *(bf16x8*)(WT + (size_t)(n0 + n) * K + k0 + k8) = pack8(v);
    }
    __syncthreads();
}

__device__ void prologue(const Params& p, unsigned char* lds) {
    int tid_l = threadIdx.x; asm volatile("" : "+v"(tid_l)); const int tid = tid_l, wid = tid >> 6, lane = tid & 63;
    float* SS = (float*)(p.ws + WS_SS);
    for (size_t i = (size_t)blockIdx.x * 512 + tid; i < 4ull * T_ALL; i += (size_t)gridDim.x * 512) SS[T_ALL + i] = 0.f;
    constexpr int NW_L = 3200, NW = 6400, NX = T_ALL / 8;
    for (int it = blockIdx.x; it < NW + NX; it += gridDim.x) {
        if (it < NW) {
            const int l = it / NW_L; int r = it % NW_L;
            if (r < 896) wt_tile(p.w_in + (size_t)l * DM * NIN, DM, NIN, p.norm1_g + l * DM, (bf16_t*)(p.ws + WS_WIN) + (size_t)l * NIN * DM, r / 56, r % 56, lds);
            else if (r < 1152) { r -= 896; wt_tile(p.w_out + (size_t)l * DM * DM, DM, DM, nullptr, (bf16_t*)(p.ws + WS_WOUT) + (size_t)l * DM * DM, r / 16, r % 16, lds); }
            else if (r < 2176) { r -= 1152; wt_tile(p.w_up + (size_t)l * DM * DFF, DM, DFF, p.norm2_g + l * DM, (bf16_t*)(p.ws + WS_WUP) + (size_t)l * DFF * DM, r / 64, r % 64, lds); }
            else { r -= 2176; wt_tile(p.w_down + (size_t)l * DFF * DM, DFF, DM, nullptr, (bf16_t*)(p.ws + WS_WDN) + (size_t)l * DM * DFF, r / 16, r % 16, lds); }
        } else {
            const int row = (it - NW) * 8 + wid;
            const float* xr = row >= T_P ? p.x_sample + (size_t)(row - T_P) * DM : p.x_prompt + (size_t)row * DM;
            bf16_t* xb = (bf16_t*)(p.ws + WS_XB) + (size_t)row * DM;
            float s = 0.f;
#pragma unroll
            for (int i = 0; i < 4; ++i) {
                const f32x4 v = *(const f32x4*)(xr + lane * 4 + 256 * i);
                s += v[0] * v[0] + v[1] * v[1] + v[2] * v[2] + v[3] * v[3];
                u32x2 o; o[0] = pk2(v[0], v[1]); o[1] = pk2(v[2], v[3]);
                *(u32x2*)(xb + lane * 4 + 256 * i) = o;
            }
#pragma unroll
            for (int o = 32; o > 0; o >>= 1) s += __shfl_xor(s, o, 64);
            if (lane == 0) SS[row] = s;
        }
    }
}

__device__ void final_norm(const Params& p) {
    int tid_l = threadIdx.x; asm volatile("" : "+v"(tid_l)); const int tid = tid_l, wid = tid >> 6, lane = tid & 63;
    const float* SS4 = (const float*)(p.ws + WS_SS) + 4 * T_ALL;
    for (int it = blockIdx.x; it < T_ALL / 8; it += gridDim.x) {
        const int row = it * 8 + wid;
        float* xr = p.out + (size_t)row * DM;
        const float rstd = rsqrtf(SS4[row] * (1.0f / 1024.0f) + EPSF);
#pragma unroll
        for (int i = 0; i < 4; ++i) {
            f32x4 v = *(const f32x4*)(xr + lane * 4 + 256 * i);
            const f32x4 g = *(const f32x4*)(p.final_g + lane * 4 + 256 * i);
            v = v * rstd * g;
            *(f32x4*)(xr + lane * 4 + 256 * i) = v;
        }
    }
}

template <bool SAMPLE>
__device__ void attn_item(const Params& p, int l, int item, unsigned char* lds) {
    int tid_l = threadIdx.x; asm volatile("" : "+v"(tid_l)); const int tid = tid_l, h = tid >> 6, lane = tid & 63, r = lane & 31, hh = lane >> 5;
    const float* tab = (const float*)lds + h * 257;
    float* ssq = (float*)(lds + 8448);
    constexpr int NQT = SAMPLE ? 1 : 2;
    const bf16_t* QA = (const bf16_t*)(p.ws + WS_QA); const bf16_t* KA = (const bf16_t*)(p.ws + WS_KA); const bf16_t* VT = (const bf16_t*)(p.ws + WS_VT);
    bf16_t* OB = (bf16_t*)(p.ws + WS_OB);
    int tq, b = 0, c = 0, jstart = 0, ntiles;
    if (SAMPLE) { tq = T_P + item * 16; ntiles = 17; }
    else { b = item >> 7; c = item & 127; tq = b * 8192 + c * 64; jstart = c * 64 - 512; if (jstart < 0) jstart = 0; ntiles = (c * 64 + 64 - jstart) >> 5; }
    bf16x8 qf[NQT][4];
#pragma unroll
    for (int qt = 0; qt < NQT; ++qt)
#pragma unroll
        for (int ks = 0; ks < 4; ++ks) {
            const int qrow = SAMPLE ? (r < 15 ? r : 15) : 32 * qt + r;
            qf[qt][ks] = *(const bf16x8*)(QA + (size_t)(tq + qrow) * 512 + h * 64 + 16 * ks + 8 * hh);
        }
    f32x16 o[2][NQT];
    float mrun[NQT], lsum[NQT];
#pragma unroll
    for (int qt = 0; qt < NQT; ++qt) { mrun[qt] = -1e30f; lsum[qt] = 0.f;
#pragma unroll
        for (int dt = 0; dt < 2; ++dt)
#pragma unroll
            for (int i = 0; i < 16; ++i) o[dt][qt][i] = 0.f; }
    for (int kt = 0; kt < ntiles; ++kt) {
        bf16x8 kf[4], vf[2][2];
        int relbase;
        const bool cache_tile = SAMPLE && kt < 16;
        if (cache_tile) {
            const float* kp = p.cache_k + ((size_t)(l * 32 + item) * 512 + kt * 32 + r) * 512 + h * 64 + 8 * hh;
#pragma unroll
            for (int ks = 0; ks < 4; ++ks) {
                const f32x4 a0 = *(const f32x4*)(kp + 16 * ks), a1 = *(const f32x4*)(kp + 16 * ks + 4);
                float t8[8] = {a0[0], a0[1], a0[2], a0[3], a1[0], a1[1], a1[2], a1[3]};
                kf[ks] = pack8(t8);
            }
            const float* vp = p.cache_v + ((size_t)(l * 32 + item) * 512 + kt * 32) * 512 + h * 64;
#pragma unroll
            for (int dt = 0; dt < 2; ++dt)
#pragma unroll
                for (int ks2 = 0; ks2 < 2; ++ks2) {
                    float t8[8];
#pragma unroll
                    for (int j = 0; j < 8; ++j) { const int key = 16 * ks2 + 8 * (j >> 2) + 4 * hh + (j & 3); t8[j] = vp[(size_t)key * 512 + 32 * dt + r]; }
                    vf[dt][ks2] = pack8(t8);
                }
            relbase = kt * 32 - 512;
        } else {
            const size_t krow = SAMPLE ? (size_t)(tq + (r < 15 ? r : 15)) : (size_t)(b * 8192 + jstart + kt * 32 + r);
#pragma unroll
            for (int ks = 0; ks < 4; ++ks) kf[ks] = *(const bf16x8*)(KA + krow * 512 + h * 64 + 16 * ks + 8 * hh);
            const size_t vcol = SAMPLE ? (size_t)tq : (size_t)(b * 8192 + jstart + kt * 32);
#pragma unroll
            for (int dt = 0; dt < 2; ++dt)
#pragma unroll
                for (int ks2 = 0; ks2 < 2; ++ks2) {
                    const bf16_t* vp = VT + (size_t)(512 + h * 64 + 32 * dt + r) * TPAD + vcol + 16 * ks2 + 4 * hh;
                    const u32x2 lo = *(const u32x2*)vp, hi = *(const u32x2*)(vp + 8);
                    u32x4v w; w[0] = lo[0]; w[1] = lo[1]; w[2] = hi[0]; w[3] = hi[1];
                    vf[dt][ks2] = __builtin_bit_cast(bf16x8, w);
                }
            relbase = SAMPLE ? 0 : (jstart + kt * 32 - c * 64);
        }
        bf16x8 pf[NQT][2];
        const bool uni = (relbase + 31 <= -128);
        const float bias0 = tab[0];
#pragma unroll
        for (int qt = 0; qt < NQT; ++qt) {
            f32x16 st;
#pragma unroll
            for (int i = 0; i < 16; ++i) st[i] = 0.f;
#pragma unroll
            for (int ks = 0; ks < 4; ++ks) st = __builtin_amdgcn_mfma_f32_32x32x16_bf16(kf[ks], qf[qt][ks], st, 0, 0, 0);
            const int q = SAMPLE ? r : 32 * qt + r;
            float sv[16];
            if (uni) {
#pragma unroll
                for (int i = 0; i < 16; ++i) sv[i] = st[i] + bias0;
            } else {
#pragma unroll
                for (int i = 0; i < 16; ++i) {
                    const int ko = (i & 3) + 8 * (i >> 2) + 4 * hh;
                    int rel = relbase + ko - q; rel = rel < -128 ? -128 : (rel > 128 ? 128 : rel);
                    sv[i] = st[i] + tab[rel + 128];
                    if (SAMPLE && !cache_tile && ko >= 16) sv[i] = -1e30f;
                }
            }
            float mx = sv[0];
#pragma unroll
            for (int i = 1; i < 16; ++i) mx = fmaxf(mx, sv[i]);
            mx = fmaxf(mx, xor32(mx));
            const float mnew = fmaxf(mrun[qt], mx), alpha = __expf(mrun[qt] - mnew);
            mrun[qt] = mnew;
            float ps = 0.f;
#pragma unroll
            for (int i = 0; i < 16; ++i) { sv[i] = __expf(sv[i] - mnew); ps += sv[i]; }
            lsum[qt] = lsum[qt] * alpha + ps;
#pragma unroll
            for (int dt = 0; dt < 2; ++dt)
#pragma unroll
                for (int i = 0; i < 16; ++i) o[dt][qt][i] *= alpha;
            pf[qt][0] = pack8(sv); pf[qt][1] = pack8(sv + 8);
        }
#pragma unroll
        for (int qt = 0; qt < NQT; ++qt)
#pragma unroll
            for (int dt = 0; dt < 2; ++dt)
#pragma unroll
                for (int ks2 = 0; ks2 < 2; ++ks2) o[dt][qt] = __builtin_amdgcn_mfma_f32_32x32x16_bf16(vf[dt][ks2], pf[qt][ks2], o[dt][qt], 0, 0, 0);
    }
#pragma unroll
    for (int qt = 0; qt < NQT; ++qt) {
        const float lt = lsum[qt] + xor32(lsum[qt]), inv = 1.0f / lt;
        float sq = 0.f;
#pragma unroll
        for (int dt = 0; dt < 2; ++dt)
#pragma unroll
            for (int i = 0; i < 16; ++i) { const float v = o[dt][qt][i] * inv; o[dt][qt][i] = v; sq += v * v; }
        sq += xor32(sq);
        if (hh == 0) ssq[h * 64 + 32 * qt + r] = sq;
    }
    __syncthreads();
    const float* ga = p.att_norm_g + l * 512 + h * 64;
#pragma unroll
    for (int qt = 0; qt < NQT; ++qt) {
        const int q = 32 * qt + r;
        float tot = 0.f;
#pragma unroll
        for (int h2 = 0; h2 < 8; ++h2) tot += ssq[h2 * 64 + q];
        const float rstd = rsqrtf(tot * (1.0f / 512.0f) + EPSF);
        if (!SAMPLE || r < 16) {
#pragma unroll
            for (int dt = 0; dt < 2; ++dt)
#pragma unroll
                for (int ig = 0; ig < 4; ++ig) {
                    const int d0 = 32 * dt + 8 * ig + 4 * hh;
                    const f32x4 g = *(const f32x4*)(ga + d0);
                    u32x2 w; w[0] = pk2(o[dt][qt][4 * ig] * rstd * g[0], o[dt][qt][4 * ig + 1] * rstd * g[1]); w[1] = pk2(o[dt][qt][4 * ig + 2] * rstd * g[2], o[dt][qt][4 * ig + 3] * rstd * g[3]);
                    *(u32x2*)(OB + (size_t)(tq + q) * DM + 512 + h * 64 + d0) = w;
                }
        }
    }
    __syncthreads();
}

struct HItem { int tb, nt, h; };
__device__ __forceinline__ HItem hitem(int it) {
    HItem x;
    if (it < 2048) { const int b = it >> 9, c = it & 127; x.h = (it >> 7) & 3; x.tb = b * 8192 + c * 64; x.nt = 64; }
    else { const int j = it - 2048; x.h = j & 3; x.tb = T_P + (j >> 2) * 16; x.nt = 16; }
    return x;
}
__device__ __forceinline__ void hgrn_cumsum(const float* LF, const HItem& X, float* tot, float (&lf)[16], float (&bb)[16], float& blast, float& bmid) {
    int tid_l = threadIdx.x; asm volatile("" : "+v"(tid_l)); const int tid = tid_l, k = tid & 127, seg = tid >> 7;
#pragma unroll
    for (int j = 0; j < 16; ++j) { const int t = seg * 16 + j; lf[j] = (t < X.nt) ? LF[(size_t)(X.tb + t) * 512 + X.h * 128 + k] : 0.f; }
    float run = 0.f;
#pragma unroll
    for (int j = 0; j < 16; ++j) { run += lf[j]; bb[j] = run; }
    tot[seg * 128 + k] = run;
    __syncthreads();
    const float t0 = tot[k], t1 = tot[128 + k], t2 = tot[256 + k], t3 = tot[384 + k];
    const float off = (seg > 0 ? t0 : 0.f) + (seg > 1 ? t1 : 0.f) + (seg > 2 ? t2 : 0.f);
    blast = t0 + t1 + t2 + t3; bmid = t0 + t1;
#pragma unroll
    for (int j = 0; j < 16; ++j) bb[j] += off;
}

__device__ void hgrn_passA(const Params& p, int it, unsigned char* lds) {
    int tid_l = threadIdx.x; asm volatile("" : "+v"(tid_l)); const int tid = tid_l, wid = tid >> 6, lane = tid & 63, r = lane & 31, hh = lane >> 5, k = tid & 127, seg = tid >> 7;
    const HItem X = hitem(it);
    float* tot = (float*)(lds + 16384); bf16_t* khT = (bf16_t*)(lds + 16384 + 2048);
    const float* LF = (const float*)(p.ws + WS_LF); const bf16_t* VT = (const bf16_t*)(p.ws + WS_VT);
    bf16_t* ST = (bf16_t*)(p.ws + WS_ST) + (size_t)it * 16384; float* D = (float*)(p.ws + WS_D) + (size_t)it * 128;
    float lf[16], bb[16], blast, bmid;
    hgrn_cumsum(LF, X, tot, lf, bb, blast, bmid);
    {
        float kh[16];
#pragma unroll
        for (int j = 0; j < 16; ++j) kh[j] = (1.0f - __expf(lf[j])) * __expf(blast - bb[j]);
        bf16_t* d = khT + k * 72 + seg * 16;
        *(bf16x8*)d = pack8(kh); *(bf16x8*)(d + 8) = pack8(kh + 8);
        if (seg == 0) D[k] = __expf(blast);
    }
    __syncthreads();
    {
        const int kt = wid & 3, vt0 = 2 * (wid >> 2);
        f32x16 acc[2];
#pragma unroll
        for (int e = 0; e < 2; ++e)
#pragma unroll
            for (int i = 0; i < 16; ++i) acc[e][i] = 0.f;
#pragma unroll
        for (int ks = 0; ks < 4; ++ks) {
            const bf16x8 a = *(const bf16x8*)(khT + (kt * 32 + r) * 72 + 16 * ks + 8 * hh);
#pragma unroll
            for (int e = 0; e < 2; ++e) {
                const bf16x8 bfr = *(const bf16x8*)(VT + (size_t)(X.h * 128 + (vt0 + e) * 32 + r) * TPAD + X.tb + 16 * ks + 8 * hh);
                acc[e] = __builtin_amdgcn_mfma_f32_32x32x16_bf16(a, bfr, acc[e], 0, 0, 0);
            }
        }
#pragma unroll
        for (int e = 0; e < 2; ++e)
#pragma unroll
            for (int ig = 0; ig < 4; ++ig) {
                u32x2 w; w[0] = pk2(acc[e][4 * ig], acc[e][4 * ig + 1]); w[1] = pk2(acc[e][4 * ig + 2], acc[e][4 * ig + 3]);
                *(u32x2*)(ST + (size_t)((vt0 + e) * 32 + r) * 128 + kt * 32 + 8 * ig + 4 * hh) = w;
            }
    }
    __syncthreads();
}

__device__ void hgrn_scan(const Params& p, int l) {
    int tid_l = threadIdx.x; asm volatile("" : "+v"(tid_l)); const int tid = tid_l;
    for (int u = blockIdx.x; u < 256 + 2048; u += gridDim.x) {
        int item0, n, sub; const float* init; float* fin;
        if (u < 256) { const int seq = u >> 4; sub = u & 15; item0 = seq * 128; n = 128; init = nullptr; fin = p.out + O_SP + ((size_t)l * 16 + seq) * 16384; }
        else { const int j = u - 256, sj = j >> 4; sub = j & 15; item0 = 2048 + sj; n = 1; init = p.state_hgrn + ((size_t)l * 128 + sj) * 16384; fin = p.out + O_SS + ((size_t)l * 128 + sj) * 16384; }
        const int e = sub * 1024 + tid * 2, v = e >> 7, k = e & 127;
        float S0 = 0.f, S1 = 0.f;
        if (init) { S0 = init[k * 128 + v]; S1 = init[(k + 1) * 128 + v]; }
        unsigned* stp = (unsigned*)((bf16_t*)(p.ws + WS_ST) + (size_t)item0 * 16384 + e);
        const float* dp = (const float*)(p.ws + WS_D) + (size_t)item0 * 128 + k;
        for (int c0 = 0; c0 < n; c0 += 8) {
            unsigned Lr[8]; float d0[8], d1[8];
#pragma unroll
            for (int j = 0; j < 8; ++j) if (c0 + j < n) { Lr[j] = stp[(size_t)(c0 + j) * 8192]; d0[j] = dp[(size_t)(c0 + j) * 128]; d1[j] = dp[(size_t)(c0 + j) * 128 + 1]; }
#pragma unroll
            for (int j = 0; j < 8; ++j) if (c0 + j < n) {
                stp[(size_t)(c0 + j) * 8192] = pk2(S0, S1);
                S0 = d0[j] * S0 + __uint_as_float(Lr[j] << 16); S1 = d1[j] * S1 + __uint_as_float(Lr[j] & 0xffff0000u);
            }
        }
        fin[k * 128 + v] = S0; fin[(k + 1) * 128 + v] = S1;
    }
}

__device__ void hgrn_passC(const Params& p, int l, int it, unsigned char* lds) {
    int tid_l = threadIdx.x; asm volatile("" : "+v"(tid_l)); const int tid = tid_l, wid = tid >> 6, lane = tid & 63, r = lane & 31, hh = lane >> 5, k = tid & 127, seg = tid >> 7;
    const HItem X = hitem(it);
    float* tot = (float*)(lds + 16384);
    bf16_t* Q1 = (bf16_t*)(lds + 16384 + 2048); bf16_t* Q2 = Q1 + 64 * 136; bf16_t* K2 = Q2 + 64 * 136;
    float* ssl = (float*)(lds + 16384 + 2048 + 3 * 17408);
    const float* LF = (const float*)(p.ws + WS_LF); const bf16_t* VT = (const bf16_t*)(p.ws + WS_VT);
    const bf16_t* QH = (const bf16_t*)(p.ws + WS_QH); const bf16_t* GH = (const bf16_t*)(p.ws + WS_GH);
    const bf16_t* ST = (const bf16_t*)(p.ws + WS_ST) + (size_t)it * 16384;
    bf16_t* OB = (bf16_t*)(p.ws + WS_OB);
    float lf[16], bb[16], blast, bmid;
    hgrn_cumsum(LF, X, tot, lf, bb, blast, bmid);
#pragma unroll
    for (int j = 0; j < 16; ++j) {
        const int t = seg * 16 + j;
        const float q = (t < X.nt) ? bf2f(QH[(size_t)(X.tb + t) * 512 + X.h * 128 + k]) : 0.f;
        Q1[t * 136 + k] = f2bf(q * __expf(bb[j]));
        Q2[t * 136 + k] = f2bf(q * __expf(bb[j] - bmid));
        K2[t * 136 + k] = f2bf((1.0f - __expf(lf[j])) * __expf(bmid - bb[j]));
    }
    __syncthreads();
    const int vt = wid >> 1, tt = wid & 1;
    f32x16 acc;
#pragma unroll
    for (int i = 0; i < 16; ++i) acc[i] = 0.f;
#pragma unroll
    for (int ks = 0; ks < 8; ++ks) {
        const bf16x8 a = *(const bf16x8*)(ST + (size_t)(vt * 32 + r) * 128 + 16 * ks + 8 * hh);
        const bf16x8 bq = *(const bf16x8*)(Q1 + (tt * 32 + r) * 136 + 16 * ks + 8 * hh);
        acc = __builtin_amdgcn_mfma_f32_32x32x16_bf16(a, bq, acc, 0, 0, 0);
    }
    for (int st = 0; st <= tt; ++st) {
        f32x16 xs;
#pragma unroll
        for (int i = 0; i < 16; ++i) xs[i] = 0.f;
#pragma unroll
        for (int ks = 0; ks < 8; ++ks) {
            const bf16x8 a = *(const bf16x8*)(K2 + (st * 32 + r) * 136 + 16 * ks + 8 * hh);
            const bf16x8 bq = *(const bf16x8*)(Q2 + (tt * 32 + r) * 136 + 16 * ks + 8 * hh);
            xs = __builtin_amdgcn_mfma_f32_32x32x16_bf16(a, bq, xs, 0, 0, 0);
        }
        float pv[16];
#pragma unroll
        for (int i = 0; i < 16; ++i) { const int s = st * 32 + (i & 3) + 8 * (i >> 2) + 4 * hh, t = tt * 32 + r; pv[i] = (s <= t) ? xs[i] : 0.f; }
#pragma unroll
        for (int ks2 = 0; ks2 < 2; ++ks2) {
            const bf16_t* vp = VT + (size_t)(X.h * 128 + vt * 32 + r) * TPAD + X.tb + st * 32 + 16 * ks2 + 4 * hh;
            const u32x2 lo = *(const u32x2*)vp, hi = *(const u32x2*)(vp + 8);
            u32x4v w; w[0] = lo[0]; w[1] = lo[1]; w[2] = hi[0]; w[3] = hi[1];
            acc = __builtin_amdgcn_mfma_f32_32x32x16_bf16(__builtin_bit_cast(bf16x8, w), pack8(pv + 8 * ks2), acc, 0, 0, 0);
        }
    }
    const int t = tt * 32 + r;
    {
        float sq = 0.f;
#pragma unroll
        for (int i = 0; i < 16; ++i) sq += acc[i] * acc[i];
        sq += xor32(sq);
        if (hh == 0) ssl[vt * 64 + t] = sq;
    }
    __syncthreads();
    {
        const float rstd = rsqrtf((ssl[t] + ssl[64 + t] + ssl[128 + t] + ssl[192 + t]) * (1.0f / 128.0f) + EPSF);
        if (t < X.nt) {
            const float* gh = p.hg_norm_g + l * 512 + X.h * 128;
#pragma unroll
            for (int ig = 0; ig < 4; ++ig) {
                const int v0 = vt * 32 + 8 * ig + 4 * hh;
                const f32x4 g = *(const f32x4*)(gh + v0);
                const u32x2 gg = *(const u32x2*)(GH + (size_t)(X.tb + t) * 512 + X.h * 128 + v0);
                const float s0 = __uint_as_float(gg[0] << 16), s1 = __uint_as_float(gg[0] & 0xffff0000u), s2 = __uint_as_float(gg[1] << 16), s3 = __uint_as_float(gg[1] & 0xffff0000u);
                u32x2 w; w[0] = pk2(acc[4 * ig] * rstd * g[0] * s0, acc[4 * ig + 1] * rstd * g[1] * s1); w[1] = pk2(acc[4 * ig + 2] * rstd * g[2] * s2, acc[4 * ig + 3] * rstd * g[3] * s3);
                *(u32x2*)(OB + (size_t)(X.tb + t) * DM + X.h * 128 + v0) = w;
            }
        }
    }
    __syncthreads();
}

__device__ __forceinline__ int lbid() { int x = blockIdx.x; asm volatile("" : "+s"(x)); return x; }
__device__ __forceinline__ int lgrid() { int x = gridDim.x; asm volatile("" : "+s"(x)); return x; }
__device__ __forceinline__ void my_grid_sync(unsigned* bar, unsigned target) {
    int t = threadIdx.x; asm volatile("" : "+v"(t));
    __syncthreads();
    if (t == 0) {
        __threadfence();
        __hip_atomic_fetch_add(bar, 1u, __ATOMIC_RELEASE, __HIP_MEMORY_SCOPE_AGENT);
        while (__hip_atomic_load(bar, __ATOMIC_RELAXED, __HIP_MEMORY_SCOPE_AGENT) < target) __builtin_amdgcn_s_sleep(2);
        __threadfence();
    }
    __syncthreads();
}
#ifndef ONLY
#define ONLY -1
#endif
__global__ void __launch_bounds__(512, 2) hymba_fwd(Params p_unused) {
    extern __shared__ __attribute__((aligned(16))) unsigned char lds[];
    int lo, hi; { KP kp = kparams(); lo = kp->ph_lo; hi = kp->ph_hi; }
#ifndef SKIPP
#define SKIPP -2
#endif
#define PHID(k) ((k) == 0 ? 0 : (k) == 15 ? 15 : ((k) - 1) % 7 + 1)
#define IN(k) (lo <= (k) && (k) < hi && (ONLY < 0 || ONLY == PHID(k)) && SKIPP != PHID(k))
    unsigned nsync = 0;
#define SEAM(k) do { if (IN(k) && IN((k) + 1)) { cg::this_grid().sync(); } } while (0)
    if (IN(0)) { const Params p = load_params(); prologue(p, lds); }
    if (IN(0) && IN(1)) cg::this_grid().sync();
    for (int l = 0; l < 2; ++l) {
        const int base = 1 + 7 * l;
        if (IN(base)) {
            const Params p = load_params(); unsigned char* ws = p.ws;
            pg8::Gemm g{(const bf16_t*)(ws + WS_XB), (const bf16_t*)(ws + WS_WIN) + (size_t)l * NIN * DM, T_ALL, NIN, DM};
            pg8::StaticOrder S; S.init(T_ALL, NIN, lgrid(), lbid());
            EpiIn E{l};
            pg8::gemm_phase<EpiIn, pg8::StaticOrder, false>((PG8_LAS unsigned char*)lds, g, S, E, nullptr);
        }
        SEAM(base);
        if (IN(base + 1)) {
            const Params p = load_params(); const int G = gridDim.x, bx = blockIdx.x;
            __syncthreads();
            for (int i = threadIdx.x; i < 8 * 257; i += 512) ((float*)lds)[i] = p.rel_bias[l * 8 * 257 + i];
            __syncthreads();
            for (int it = bx; it < 512; it += G) attn_item<false>(p, l, it, lds);
            for (int it = bx; it < 32; it += G) attn_item<true>(p, l, it, lds);
            for (int it = bx; it < 2176; it += G) hgrn_passA(p, it, lds);
        }
        SEAM(base + 1);
        if (IN(base + 2)) { const Params p = load_params(); hgrn_scan(p, l); }
        SEAM(base + 2);
        if (IN(base + 3)) { const Params p = load_params(); __syncthreads(); for (int it = blockIdx.x; it < 2176; it += gridDim.x) hgrn_passC(p, l, it, lds); }
        SEAM(base + 3);
        if (IN(base + 4)) {
            const Params p = load_params(); unsigned char* ws = p.ws;
            __syncthreads();
            pg8::Gemm g{(const bf16_t*)(ws + WS_OB), (const bf16_t*)(ws + WS_WOUT) + (size_t)l * DM * DM, T_ALL, DM, DM};
            pg8::StaticOrder S; S.init(T_ALL, DM, lgrid(), lbid());
            EpiRes<0> E{l};
            pg8::gemm_phase<EpiRes<0>, pg8::StaticOrder, false>((PG8_LAS unsigned char*)lds, g, S, E, nullptr);
        }
        SEAM(base + 4);
        if (IN(base + 5)) {
            const Params p = load_params(); unsigned char* ws = p.ws;
            pg8::Gemm g{(const bf16_t*)(ws + WS_XB), (const bf16_t*)(ws + WS_WUP) + (size_t)l * DFF * DM, T_ALL, DFF, DM};
            pg8::StaticOrder S; S.init(T_ALL, DFF, lgrid(), lbid());
            EpiUp E{l};
            pg8::gemm_phase<EpiUp, pg8::StaticOrder, false>((PG8_LAS unsigned char*)lds, g, S, E, nullptr);
        }
        SEAM(base + 5);
        if (IN(base + 6)) {
            const Params p = load_params(); unsigned char* ws = p.ws;
            pg8::Gemm g{(const bf16_t*)(ws + WS_U), (const bf16_t*)(ws + WS_WDN) + (size_t)l * DM * DFF, T_ALL, DM, DFF};
            pg8::StaticOrder S; S.init(T_ALL, DM, lgrid(), lbid());
            EpiRes<1> E{l};
            pg8::gemm_phase<EpiRes<1>, pg8::StaticOrder, false>((PG8_LAS unsigned char*)lds, g, S, E, nullptr);
        }
        SEAM(base + 6);
    }
    if (IN(15)) { const Params p = load_params(); final_norm(p); }
#undef IN
#undef SEAM
}

extern "C" void kernel_launch(void* const* d_in, const int* in_sizes, int n_in, void* d_out, int out_size, void* d_ws, size_t ws_size, hipStream_t stream) {
    static int grid = 0;
    if (grid == 0) {
        if (n_in != 16 || ws_size < WS_END) { fprintf(stderr, "kernel_launch: need 16 inputs and >= %zu bytes of workspace; got %d, %zu\n", (size_t)WS_END, n_in, ws_size); grid = -1; return; }
        int dev = 0, cus = 0, per_cu = 0;
        (void)hipGetDevice(&dev); (void)hipDeviceGetAttribute(&cus, hipDeviceAttributeMultiprocessorCount, dev);
        if (hipFuncSetAttribute((const void*)hymba_fwd, hipFuncAttributeMaxDynamicSharedMemorySize, LDS_BYTES) != hipSuccess) { fprintf(stderr, "kernel_launch: hipFuncSetAttribute failed\n"); grid = -1; return; }
        if (hipOccupancyMaxActiveBlocksPerMultiprocessor(&per_cu, (const void*)hymba_fwd, 512, LDS_BYTES) != hipSuccess || per_cu < 1) { fprintf(stderr, "kernel_launch: occupancy query says %d\n", per_cu); per_cu = 1; }
        (void)hipGetLastError();
        grid = cus;
    }
    if (grid < 0) return;
    Params p{};
    const float** pp = (const float**)&p;
    for (int i = 0; i < 16; ++i) pp[i] = (const float*)d_in[i];
    p.out = (float*)d_out; p.ws = (unsigned char*)d_ws;
#if MK_ONE_LAUNCH
    (void)hipMemsetAsync((unsigned char*)d_ws + WS_BAR, 0, 256, stream);
    p.ph_lo = 0; p.ph_hi = 16;
    void* args[] = {&p};
    hipError_t e = hipLaunchCooperativeKernel((const void*)hymba_fwd, dim3(grid), dim3(512), args, LDS_BYTES, stream);
    if (e != hipSuccess) fprintf(stderr, "cooperative launch failed: %s (grid %d)\n", hipGetErrorString(e), grid);
#else
    for (int ph = 0; ph < 16; ++ph) { p.ph_lo = ph; p.ph_hi = ph + 1; hipLaunchKernelGGL(hymba_fwd, dim3(grid), dim3(512), LDS_BYTES, stream, p); }
#endif
}
```

```cpp
#include <hip/hip_runtime.h>
#include <hip/hip_cooperative_groups.h>
#include <cstdio>
namespace cg = cooperative_groups;
namespace pg8 {
#define PG8_LAS __attribute__((address_space(3)))
typedef unsigned short bf16_t;
typedef short bf16x8 __attribute__((ext_vector_type(8)));
typedef float f32x4 __attribute__((ext_vector_type(4)));
typedef unsigned u32x4 __attribute__((ext_vector_type(4)));
constexpr int BM = 256, BK = 64, HALF = 128, HTB = HALF * BK * 2  , STAGE_BYTES = 8 * HTB, NXCD = 8, WGM = 8;

__host__ __device__ __forceinline__ int lds_byte(int r, int c) { const int st = (r >> 4) * 2 + (c >> 5), rr = r & 15, cc = c & 31, ob = rr * 64 + cc * 2; return st * 1024 + (ob ^ (((ob >> 9) & 1) << 5)); }
__host__ __device__ __forceinline__ void stage_rc(int b, int& R, int& C) { const int st = b / 1024, sb = b % 1024, swz = sb ^ (((sb >> 9) & 1) << 5); R = (st >> 1) * 16 + swz / 64; C = (st & 1) * 32 + (swz % 64) / 2; }
__host__ __device__ __forceinline__ int perm32(int rho) { const int n = rho >> 4, i = rho & 15; return 8 * (i >> 2) + 4 * n + (i & 3); }

struct Unit { int pm, pn, k0; };
struct Gemm { const bf16_t* A; const bf16_t* Bt; int M, N, K, ld; };

struct StaticOrder {
    int nM, nN, nwg, G, c;
    __host__ __device__ void init(int M, int N, int G_, int c_) { nM = M / BM; nN = N / BM; nwg = nM * nN; G = G_; c = c_; }
    __host__ __device__ bool next(int i, Unit& u) const {
        const long L = (long)i * G + c; if (L >= nwg) return false;
        int wgid = (int)L; { const int q = nwg / NXCD, r = nwg % NXCD, xcd = wgid % NXCD, off = wgid / NXCD; wgid = (xcd < r ? xcd * (q + 1) : r * (q + 1) + (xcd - r) * q) + off; }
        const int nig = WGM * nN, gid = wgid / nig, fm = gid * WGM, gsz = (nM - fm) < WGM ? (nM - fm) : WGM;
        u.pm = fm + ((wgid % nig) % gsz); u.pn = (wgid % nig) / gsz; u.k0 = 0; return true;
    }
    __device__ __forceinline__ void a_ready(const Unit&) const {}
    __device__ __forceinline__ void done(const Unit&) const {}
};
__device__ __forceinline__ unsigned cvt_pk_bf16(float lo, float hi) { unsigned r; asm volatile("v_cvt_pk_bf16_f32 %0, %1, %2" : "=v"(r) : "v"(lo), "v"(hi)); return r; }

template <class Epi, class Sched, bool STAMP = false>
__device__ __forceinline__ void gemm_phase(PG8_LAS unsigned char* lds, const Gemm g, const Sched& S, const Epi& E, unsigned long long* stamps) {
    int tid_l = threadIdx.x; asm volatile("" : "+v"(tid_l)); const int tid = tid_l, wid = __builtin_amdgcn_readfirstlane(tid >> 6), lane = tid & 63, wr = wid >> 2, wc = wid & 3, fr = lane & 15, fq = lane >> 4;
    const int K = g.K, nt = K / BK, LD = g.ld;
    int ts_lo = 0, ts_hi = 0, nts = 0; const unsigned long long rt_entry = STAMP ? (unsigned long long)wall_clock64() : 0ull;
#define PG8_STAMP() do { if (STAMP && wid == 0 && nts < 64) { const unsigned long long _c = (unsigned long long)clock64(); \
        ts_lo = (lane == nts) ? (int)(unsigned)_c : ts_lo; ts_hi = (lane == nts) ? (int)(unsigned)(_c >> 32) : ts_hi; ++nts; } } while (0)
    PG8_STAMP();
    unsigned voffA[2], voffB[2];
#pragma unroll
    for (int i = 0; i < 2; ++i) { int R, C; stage_rc(tid * 16 + i * 8192, R, C); const int Rb = Epi::PERM ? ((R & ~31) + perm32(R & 31)) : R;
        voffA[i] = (unsigned)(R * LD + C) * 2u; voffB[i] = (unsigned)(Rb * LD + C) * 2u; }
    const size_t kstep = (size_t)(BK * 2);
    const size_t hstep = (size_t)HALF * LD * 2;
    const size_t tstep = 2 * hstep;
    const unsigned ldsw = (unsigned)wid * 1024u;
    const int aoff = lds_byte(wr * 64 + fr, fq * 8), boff = lds_byte(wc * 32 + fr, fq * 8);
#define PG8_SA(b, h) (((b) * 2 + (h)) * HTB)
#define PG8_SB(b, h) ((4 + (b) * 2 + (h)) * HTB)
#define PG8_STAGE(bufoff, gbase, voff) do { _Pragma("unroll") for (int _i = 0; _i < 2; ++_i) \
        __builtin_amdgcn_global_load_lds((const unsigned*)((const char*)(gbase) + (voff)[_i]), (PG8_LAS unsigned*)(lds + (bufoff) + ldsw + _i * 8192), 16, 0, 0); } while (0)
#define PG8_LDA(dst, b, h) do { _Pragma("unroll") for (int m = 0; m < 4; ++m) _Pragma("unroll") for (int k = 0; k < 2; ++k) dst[m][k] = *(const PG8_LAS bf16x8*)(lds + PG8_SA(b, h) + aoff + m * 2048 + k * 1024); } while (0)
#define PG8_LDB(dst, b, h) do { _Pragma("unroll") for (int n = 0; n < 2; ++n) _Pragma("unroll") for (int k = 0; k < 2; ++k) dst[n][k] = *(const PG8_LAS bf16x8*)(lds + PG8_SB(b, h) + boff + n * 2048 + k * 1024); } while (0)
#define PG8_MMA(ai, bj, At, Bt) do { __builtin_amdgcn_s_setprio(1); _Pragma("unroll") for (int m = 0; m < 4; ++m) _Pragma("unroll") for (int n = 0; n < 2; ++n) _Pragma("unroll") for (int k = 0; k < 2; ++k) \
        acc[ai][bj][m][n] = __builtin_amdgcn_mfma_f32_16x16x32_bf16(Bt[n][k], At[m][k], acc[ai][bj][m][n], 0, 0, 0); __builtin_amdgcn_s_setprio(0); } while (0)
#define PG8_WAIT_V(n) asm volatile("s_waitcnt vmcnt(" #n ")" ::: "memory")
#define PG8_WAIT_L(n) asm volatile("s_waitcnt lgkmcnt(" #n ")" ::: "memory")
#define PG8_BAR __builtin_amdgcn_s_barrier()
#define PG8_SCHED __builtin_amdgcn_sched_barrier(0)
    Unit cur, nxt; int ui = 0;
    if (!S.next(0, cur)) return;
    f32x4 acc[2][2][4][2];
#pragma unroll
    for (int a = 0; a < 2; ++a)
#pragma unroll
        for (int b = 0; b < 2; ++b)
#pragma unroll
            for (int m = 0; m < 4; ++m)
#pragma unroll
                for (int n = 0; n < 2; ++n) acc[a][b][m][n] = (f32x4){0.f, 0.f, 0.f, 0.f};
    bf16x8 At[4][2], B0[2][2], B1[2][2];
    const char* cA = (const char*)g.A + (size_t)cur.pm * tstep + (size_t)cur.k0 * 2; const char* cB = (const char*)g.Bt + (size_t)cur.pn * tstep + (size_t)cur.k0 * 2;
    S.a_ready(cur);
    PG8_STAGE(PG8_SB(0, 0), cB, voffB); PG8_STAGE(PG8_SA(0, 0), cA, voffA); PG8_STAGE(PG8_SB(0, 1), cB + hstep, voffB); PG8_STAGE(PG8_SA(0, 1), cA + hstep, voffA);
    if (wr == 1) PG8_BAR;
    PG8_WAIT_V(4); PG8_BAR;
    PG8_STAGE(PG8_SB(1, 0), cB + kstep, voffB); PG8_STAGE(PG8_SA(1, 0), cA + kstep, voffA); PG8_STAGE(PG8_SB(1, 1), cB + hstep + kstep, voffB);
    PG8_WAIT_V(6); PG8_BAR;
    PG8_STAMP();
    for (;;) {
        const bool has_next = S.next(ui + 1, nxt);
        const char* nA = has_next ? (const char*)g.A + (size_t)nxt.pm * tstep + (size_t)nxt.k0 * 2 : cA; const char* nB = has_next ? (const char*)g.Bt + (size_t)nxt.pn * tstep + (size_t)nxt.k0 * 2 : cB;
        for (int t = 0; t < nt; t += 2) {
            const bool last = (t == nt - 2);
            const char* a1 = cA + (size_t)(t + 1) * kstep;
            const char* a2 = last ? nA : cA + (size_t)(t + 2) * kstep; const char* b2 = last ? nB : cB + (size_t)(t + 2) * kstep;
            const char* a3 = a2 + kstep; const char* b3 = b2 + kstep;
            if (last && has_next) S.a_ready(nxt);
            PG8_LDB(B0, 0, 0); PG8_SCHED; PG8_LDA(At, 0, 0); PG8_STAGE(PG8_SA(1, 1), a1 + hstep, voffA);
            PG8_WAIT_L(8); PG8_BAR; PG8_WAIT_L(0); PG8_MMA(0, 0, At, B0); PG8_BAR; PG8_SCHED;
            PG8_LDB(B1, 0, 1); PG8_STAGE(PG8_SB(0, 0), b2, voffB);
            PG8_BAR; PG8_WAIT_L(0); PG8_MMA(0, 1, At, B1); PG8_BAR;
            PG8_LDA(At, 0, 1); PG8_STAGE(PG8_SA(0, 0), a2, voffA);
            PG8_BAR; PG8_WAIT_L(0); PG8_MMA(1, 0, At, B0); PG8_BAR; PG8_SCHED;
            PG8_STAGE(PG8_SB(0, 1), b2 + hstep, voffB);
            PG8_WAIT_V(6); PG8_BAR; PG8_MMA(1, 1, At, B1); PG8_BAR;
            PG8_LDB(B0, 1, 0); PG8_SCHED; PG8_LDA(At, 1, 0); PG8_STAGE(PG8_SA(0, 1), a2 + hstep, voffA);
            PG8_WAIT_L(8); PG8_BAR; PG8_WAIT_L(0); PG8_MMA(0, 0, At, B0); PG8_BAR; PG8_SCHED;
            PG8_LDB(B1, 1, 1); PG8_STAGE(PG8_SB(1, 0), b3, voffB);
            PG8_BAR; PG8_WAIT_L(0); PG8_MMA(0, 1, At, B1); PG8_BAR;
            PG8_LDA(At, 1, 1); PG8_STAGE(PG8_SA(1, 0), a3, voffA);
            PG8_BAR; PG8_WAIT_L(0); PG8_MMA(1, 0, At, B0); PG8_BAR; PG8_SCHED;
            PG8_STAGE(PG8_SB(1, 1), b3 + hstep, voffB);
            PG8_WAIT_V(6); PG8_BAR; PG8_MMA(1, 1, At, B1); PG8_BAR;
        }
        PG8_STAMP();
        if constexpr (!Epi::AFTER_DRAIN) { E(acc, cur, wr, wc, fr, fq); S.done(cur); }
        PG8_STAMP();
        if (!has_next) break;
#pragma unroll
        for (int a = 0; a < 2; ++a)
#pragma unroll
            for (int b = 0; b < 2; ++b)
#pragma unroll
                for (int m = 0; m < 4; ++m)
#pragma unroll
                    for (int n = 0; n < 2; ++n) acc[a][b][m][n] = (f32x4){0.f, 0.f, 0.f, 0.f};
        cur = nxt; cA = nA; cB = nB; ++ui;
    }
    PG8_WAIT_V(0);
    if (wr == 0) PG8_BAR;
    PG8_BAR;
    if constexpr (Epi::AFTER_DRAIN) { E.fused(acc, cur, wr, wc, fr, fq, lds, wid, lane); S.done(cur); }
    PG8_STAMP();
    if (STAMP && wid == 0) { stamps[lane] = lane < nts ? (((unsigned long long)(unsigned)ts_hi << 32) | (unsigned)ts_lo) : 0ull;
        if (lane == 62) stamps[62] = rt_entry; if (lane == 63) stamps[63] = (unsigned long long)wall_clock64(); }
#undef PG8_STAMP
#undef PG8_SA
#undef PG8_SB
#undef PG8_STAGE
#undef PG8_LDA
#undef PG8_LDB
#undef PG8_MMA
#undef PG8_WAIT_V
#undef PG8_WAIT_L
#undef PG8_BAR
#undef PG8_SCHED
}
}

using pg8::bf16_t; using pg8::bf16x8; using pg8::f32x4; using pg8::Unit;
typedef float f32x16 __attribute__((ext_vector_type(16)));
typedef unsigned u32x2 __attribute__((ext_vector_type(2)));
typedef unsigned u32x4v __attribute__((ext_vector_type(4)));

#ifndef MK_ONE_LAUNCH
#define MK_ONE_LAUNCH 1
#endif

constexpr int T_P = 32768, T_S = 512, T_ALL = 33280, DM = 1024, NIN = 3584, DFF = 4096, TPAD = 33344;
constexpr float EPSF = 1e-6f;
constexpr size_t O_Y = 0, O_SP = 34078720, O_KP = 34603008, O_VP = 36700160, O_SS = 38797312, O_KS = 42991616, O_VS = 43515904;
constexpr size_t WS_WIN = 0, WS_WOUT = WS_WIN + 2ull * NIN * DM * 2, WS_WUP = WS_WOUT + 2ull * DM * DM * 2, WS_WDN = WS_WUP + 2ull * DFF * DM * 2,
                 WS_XB = WS_WDN + 2ull * DFF * DM * 2, WS_OB = WS_XB + (size_t)T_ALL * DM * 2, WS_U = WS_OB + (size_t)T_ALL * DM * 2,
                 SZ_P = (size_t)T_ALL * 512 * 2, WS_QH = WS_U, WS_GH = WS_U + SZ_P, WS_QA = WS_U + 2 * SZ_P, WS_KA = WS_U + 3 * SZ_P, WS_LF = WS_U + 4 * SZ_P,
                 WS_VT = WS_LF + (size_t)T_ALL * 512 * 4, WS_ST = WS_VT + (size_t)1024 * TPAD * 2, N_ITEMS = 2176, WS_D = WS_ST + N_ITEMS * 32768ull,
                 WS_SS = WS_D + N_ITEMS * 512ull, WS_BAR = WS_SS + 5ull * T_ALL * 4, WS_LB = WS_BAR + 16384, WS_END = WS_LB + 4096;
static_assert(WS_VT + (size_t)1024 * TPAD * 2 >= WS_U + (size_t)T_ALL * DFF * 2, "U region");
constexpr int LDS_BYTES = pg8::STAGE_BYTES + 8 * 2560 + 16;

struct Params {
    const float *x_prompt, *x_sample, *state_hgrn, *cache_k, *cache_v, *lb_param, *norm1_g, *w_in, *hg_norm_g, *rel_bias, *att_norm_g, *w_out, *norm2_g, *w_up, *w_down, *final_g;
    float* out; unsigned char* ws; int ph_lo, ph_hi;
};

__device__ __forceinline__ float bf2f(bf16_t b) { return __uint_as_float(((unsigned)b) << 16); }
__device__ __forceinline__ bf16_t f2bf(float f) { unsigned u = __float_as_uint(f); u += 0x7fffu + ((u >> 16) & 1u); return (bf16_t)(u >> 16); }
typedef __bf16 bf16v2_t __attribute__((ext_vector_type(2)));
__device__ __forceinline__ unsigned pk2(float lo, float hi) { bf16v2_t v; v[0] = (__bf16)lo; v[1] = (__bf16)hi; return __builtin_bit_cast(unsigned, v); }
__device__ __forceinline__ bf16x8 pack8(const float* v) {
    u32x4v r; r[0] = pk2(v[0], v[1]); r[1] = pk2(v[2], v[3]); r[2] = pk2(v[4], v[5]); r[3] = pk2(v[6], v[7]);
    return __builtin_bit_cast(bf16x8, r);
}
__device__ __forceinline__ float xor32(float v) { return __shfl_xor(v, 32, 64); }

typedef const Params __attribute__((address_space(4)))* KP;
__device__ __forceinline__ KP kparams() { unsigned long long a = (unsigned long long)__builtin_amdgcn_kernarg_segment_ptr(); asm volatile("" : "+s"(a)); return (KP)a; }
__device__ __forceinline__ Params load_params() { KP kp = kparams(); Params p; p.x_prompt = kp->x_prompt; p.x_sample = kp->x_sample; p.state_hgrn = kp->state_hgrn; p.cache_k = kp->cache_k; p.cache_v = kp->cache_v; p.lb_param = kp->lb_param; p.norm1_g = kp->norm1_g; p.w_in = kp->w_in; p.hg_norm_g = kp->hg_norm_g; p.rel_bias = kp->rel_bias; p.att_norm_g = kp->att_norm_g; p.w_out = kp->w_out; p.norm2_g = kp->norm2_g; p.w_up = kp->w_up; p.w_down = kp->w_down; p.final_g = kp->final_g; p.out = kp->out; p.ws = kp->ws; p.ph_lo = kp->ph_lo; p.ph_hi = kp->ph_hi; return p; }
#ifndef NOTYPE
#define NOTYPE -1
#endif
struct EpiIn {
    static constexpr bool PERM = true, AFTER_DRAIN = false;
    int l; PG8_LAS unsigned char* xt; int skip;
    template <int TYPE> __device__ __forceinline__ void run(const f32x4 (&acc)[2][2][4][2], const Unit& u, int wr, int wc, int fr, int fq) const {
        const Params P = load_params(); unsigned char* ws = P.ws; const float* ss = (const float*)(ws + WS_SS) + 2 * l * T_ALL; const float* lbp = P.lb_param; float* out = P.out;
        bf16_t* QH = (bf16_t*)(ws + WS_QH); bf16_t* GH = (bf16_t*)(ws + WS_GH); bf16_t* QA = (bf16_t*)(ws + WS_QA); bf16_t* KA = (bf16_t*)(ws + WS_KA); bf16_t* VT = (bf16_t*)(ws + WS_VT); float* LF = (float*)(ws + WS_LF);
        (void)lbp; (void)out; (void)QH; (void)GH; (void)QA; (void)KA; (void)VT; (void)LF;
        const int cbase = (u.pn & 1) * 256 + wc * 32 + 8 * fq;
        f32x4 lbv[2][2];
        if constexpr (TYPE == 1) { const float* LB = (const float*)(ws + WS_LB) + l * 512 + cbase;
#pragma unroll
            for (int bj = 0; bj < 2; ++bj) { lbv[bj][0] = *(const f32x4*)(LB + bj * 128); lbv[bj][1] = *(const f32x4*)(LB + bj * 128 + 4); } }
        float rs8[2][4];
#pragma unroll
        for (int ai = 0; ai < 2; ++ai)
#pragma unroll
            for (int m = 0; m < 4; ++m) rs8[ai][m] = ss[u.pm * 256 + ai * 128 + wr * 64 + m * 16 + fr];
#pragma unroll
        for (int ai = 0; ai < 2; ++ai) {
            float rs4[4];
#pragma unroll
            for (int m = 0; m < 4; ++m) rs4[m] = rsqrtf(rs8[ai][m] * (1.0f / 1024.0f) + EPSF);
#pragma unroll
            for (int bj = 0; bj < 2; ++bj)
#pragma unroll
                for (int m = 0; m < 4; ++m) {
                    const int row = u.pm * 256 + ai * 128 + wr * 64 + m * 16 + fr;
                    const float rstd = rs4[m];
                    const int cb = cbase + bj * 128;
                    float v[8];
#pragma unroll
                    for (int j = 0; j < 4; ++j) { v[j] = acc[ai][bj][m][0][j] * rstd; v[4 + j] = acc[ai][bj][m][1][j] * rstd; }
                    if constexpr (TYPE == 0) { *(bf16x8*)(QH + (size_t)row * 512 + cb) = pack8(v); }
                    else if constexpr (TYPE == 1) {
                        float o[8];
#pragma unroll
                        for (int j = 0; j < 8; ++j) {
                            const float lb = j < 4 ? lbv[bj][0][j & 3] : lbv[bj][1][j & 3];
                            const float sg = __builtin_amdgcn_rcpf(1.0f + __expf(-v[j]));
                            o[j] = __builtin_amdgcn_logf(lb + (1.0f - lb) * sg) * 0.6931471805599453f;
                        }
                        float* d = LF + (size_t)row * 512 + cb;
                        *(f32x4*)d = (f32x4){o[0], o[1], o[2], o[3]}; *(f32x4*)(d + 4) = (f32x4){o[4], o[5], o[6], o[7]};
                    }
                    else if constexpr (TYPE == 2 || TYPE == 6) {
                        PG8_LAS bf16_t* T = (PG8_LAS bf16_t*)(xt + (wr * 4 + wc) * 2560);
#pragma unroll
                        for (int j = 0; j < 8; ++j) T[(8 * fq + j) * 36 + 16 * (m & 1) + fr] = f2bf(v[j]);
                        if (m & 1) {
                            asm volatile("s_waitcnt lgkmcnt(0)" ::: "memory");
                            const int lane = fq * 16 + fr, col = lane >> 1, half = lane & 1;
                            const PG8_LAS u32x2* src = (const PG8_LAS u32x2*)(T + col * 36 + 16 * half);
                            const u32x2 a0 = src[0], a1 = src[1], a2 = src[2], a3 = src[3];
                            bf16_t* d = VT + (size_t)((TYPE == 6 ? 512 : 0) + (u.pn & 1) * 256 + wc * 32 + bj * 128 + col) * TPAD + (u.pm * 256 + ai * 128 + wr * 64 + (m - 1) * 16 + 16 * half);
                            u32x4v w0, w1; w0[0] = a0[0]; w0[1] = a0[1]; w0[2] = a1[0]; w0[3] = a1[1]; w1[0] = a2[0]; w1[1] = a2[1]; w1[2] = a3[0]; w1[3] = a3[1];
                            *(u32x4v*)d = w0; *(u32x4v*)(d + 8) = w1;
                            asm volatile("s_waitcnt lgkmcnt(0)" ::: "memory");
                        }
                    }
                    else if constexpr (TYPE == 3) {
                        float o[8];
#pragma unroll
                        for (int j = 0; j < 8; ++j) o[j] = v[j] * __builtin_amdgcn_rcpf(1.0f + __expf(-v[j]));
                        *(bf16x8*)(GH + (size_t)row * 512 + cb) = pack8(o);
                    }
                    else if constexpr (TYPE == 4) {
                        float o[8];
#pragma unroll
                        for (int j = 0; j < 8; ++j) o[j] = v[j] * (0.125f * 1.4426950408889634f);
                        *(bf16x8*)(QA + (size_t)row * 512 + cb) = pack8(o);
                    }
                    if constexpr (TYPE == 5) { *(bf16x8*)(KA + (size_t)row * 512 + cb) = pack8(v); }
                    if constexpr (TYPE == 5 || TYPE == 6) {
                        float* d = nullptr;
                        if (row >= T_P) d = out + (TYPE == 5 ? O_KS : O_VS) + ((size_t)l * 512 + (row - T_P)) * 512 + cb;
                        else { const int t = row & 8191, b = row >> 13; if (t >= 7680) d = out + (TYPE == 5 ? O_KP : O_VP) + (((size_t)l * 4 + b) * 512 + (t - 7680)) * 512 + cb; }
                        if (d) { *(f32x4*)d = (f32x4){v[0], v[1], v[2], v[3]}; *(f32x4*)(d + 4) = (f32x4){v[4], v[5], v[6], v[7]}; }
                    }
                }
        }
    }
    __device__ __forceinline__ void operator()(const f32x4 (&acc)[2][2][4][2], const Unit& u, int wr, int wc, int fr, int fq) const {
#ifndef PMASK
#define PMASK 0
#endif
        if (skip && !((PMASK >> (u.pn >> 1)) & 1)) return;
        switch (u.pn >> 1) {
            case 0: if (NOTYPE != 0) run<0>(acc, u, wr, wc, fr, fq); break;
            case 1: if (NOTYPE != 1) run<1>(acc, u, wr, wc, fr, fq); break;
            case 2: if (NOTYPE != 2) run<2>(acc, u, wr, wc, fr, fq); break;
            case 3: if (NOTYPE != 3) run<3>(acc, u, wr, wc, fr, fq); break;
            case 4: if (NOTYPE != 4) run<4>(acc, u, wr, wc, fr, fq); break;
            case 5: if (NOTYPE != 5) run<5>(acc, u, wr, wc, fr, fq); break;
            default: if (NOTYPE != 6) run<6>(acc, u, wr, wc, fr, fq); break;
        }
    }
};

template <int MODE> struct EpiRes {
    static constexpr bool PERM = true, AFTER_DRAIN = false;
    int l, noatom;
    __device__ __forceinline__ void operator()(const f32x4 (&acc)[2][2][4][2], const Unit& u, int wr, int wc, int fr, int fq) const {
        const Params P = load_params(); unsigned char* ws = P.ws; bf16_t* XB = (bf16_t*)(ws + WS_XB);
        float* ssn = (float*)(ws + WS_SS) + (2 * l + 1 + MODE) * T_ALL;
        const int cbase = u.pn * 256 + wc * 32 + 8 * fq;
        bf16_t* xp = XB + (size_t)(u.pm * 256 + wr * 64 + fr) * DM + cbase;
        u32x4v rb[2][4][2];
#pragma unroll
        for (int ai = 0; ai < 2; ++ai)
#pragma unroll
            for (int m = 0; m < 4; ++m)
#pragma unroll
                for (int bj = 0; bj < 2; ++bj) rb[ai][m][bj] = *(const u32x4v*)(xp + (size_t)(ai * 128 + m * 16) * DM + bj * 128);
#pragma unroll
        for (int ai = 0; ai < 2; ++ai)
#pragma unroll
            for (int m = 0; m < 4; ++m) {
                const int row = u.pm * 256 + ai * 128 + wr * 64 + m * 16 + fr;
                float s = 0.f;
#pragma unroll
                for (int bj = 0; bj < 2; ++bj) {
                    float x[8];
                    const u32x4v r4 = rb[ai][m][bj];
#pragma unroll
                    for (int j = 0; j < 4; ++j) {
                        x[2 * j] = __uint_as_float(r4[j] << 16) + (j < 2 ? acc[ai][bj][m][0][2 * j] : acc[ai][bj][m][1][2 * j - 4]);
                        x[2 * j + 1] = __uint_as_float(r4[j] & 0xffff0000u) + (j < 2 ? acc[ai][bj][m][0][2 * j + 1] : acc[ai][bj][m][1][2 * j - 3]);
                    }
#pragma unroll
                    for (int j = 0; j < 8; ++j) s += x[j] * x[j];
                    *(bf16x8*)(xp + (size_t)(ai * 128 + m * 16) * DM + bj * 128) = pack8(x);
                }
                s += __shfl_xor(s, 16, 64); s += __shfl_xor(s, 32, 64);
                if (fq == 0 && !noatom) atomicAdd(ssn + row, s);
            }
    }
};

struct SplitOrder {
    int c;
    __device__ __forceinline__ bool next(int i, Unit& u) const { if (i != 0 || c >= 32) return false; u.pm = 128 + (c >> 4); u.pn = (c >> 2) & 3; u.k0 = (c & 3) * (DFF / 4); return true; }
    __device__ __forceinline__ void a_ready(const Unit&) const {}
    __device__ __forceinline__ void done(const Unit&) const {}
};
struct EpiSplit {
    static constexpr bool PERM = true, AFTER_DRAIN = true;
    int l;
    __device__ __forceinline__ void operator()(const f32x4 (&acc)[2][2][4][2], const Unit& u, int wr, int wc, int fr, int fq) const {}
    __device__ __forceinline__ void fused(const f32x4 (&acc)[2][2][4][2], const Unit& u, int wr, int wc, int fr, int fq, PG8_LAS unsigned char* lds, int wid, int lane) const {
        const Params P = load_params(); unsigned char* ws = P.ws; bf16_t* XB = (bf16_t*)(ws + WS_XB);
        float* PART = (float*)(ws + WS_OB);
        float* ssn = (float*)(ws + WS_SS) + (2 * l + 2) * T_ALL;
        unsigned* cnt = (unsigned*)(ws + WS_BAR) + 3584 + l * 8 + (u.pm - 128) * 4 + u.pn;
        const int ks = u.k0 / (DFF / 4);
        const int cbase = u.pn * 256 + wc * 32 + 8 * fq;
#pragma unroll
        for (int ai = 0; ai < 2; ++ai)
#pragma unroll
            for (int m = 0; m < 4; ++m) {
                const int rs = (u.pm - 128) * 256 + ai * 128 + wr * 64 + m * 16 + fr;
#pragma unroll
                for (int bj = 0; bj < 2; ++bj) {
                    float* d = PART + ((size_t)ks * 512 + rs) * DM + cbase + bj * 128;
                    *(f32x4*)d = acc[ai][bj][m][0]; *(f32x4*)(d + 4) = acc[ai][bj][m][1];
                }
            }
        __builtin_amdgcn_fence(__ATOMIC_RELEASE, "agent");
        asm volatile("s_waitcnt vmcnt(0)" ::: "memory");
        __syncthreads();
        PG8_LAS unsigned* flag = (PG8_LAS unsigned*)lds;
        if (wid == 0 && lane == 0) *flag = __hip_atomic_fetch_add(cnt, 1u, __ATOMIC_RELAXED, __HIP_MEMORY_SCOPE_AGENT);
        __syncthreads();
        const unsigned old = *flag;
        if (old != 3u) return;
        __builtin_amdgcn_fence(__ATOMIC_ACQUIRE, "agent");
#pragma unroll
        for (int ai = 0; ai < 2; ++ai)
#pragma unroll
            for (int m = 0; m < 4; ++m) {
                const int rs = (u.pm - 128) * 256 + ai * 128 + wr * 64 + m * 16 + fr, row = T_P + rs;
                float s = 0.f;
#pragma unroll
                for (int bj = 0; bj < 2; ++bj) {
                    const int c = cbase + bj * 128;
                    f32x4 pt[4][2];
                    const u32x4v rb = *(const u32x4v*)(XB + (size_t)row * DM + c);
#pragma unroll
                    for (int q = 0; q < 4; ++q) { const float* sp = PART + ((size_t)q * 512 + rs) * DM + c; pt[q][0] = *(const f32x4*)sp; pt[q][1] = *(const f32x4*)(sp + 4); }
                    f32x4 t0 = (f32x4){0.f, 0.f, 0.f, 0.f}, t1 = t0;
#pragma unroll
                    for (int q = 0; q < 4; ++q) {
                        if (q == ks) { t0 += acc[ai][bj][m][0]; t1 += acc[ai][bj][m][1]; }
                        else { t0 += pt[q][0]; t1 += pt[q][1]; }
                    }
                    float x[8];
#pragma unroll
                    for (int j = 0; j < 4; ++j) {
                        x[2 * j] = __uint_as_float(rb[j] << 16) + (j < 2 ? t0[2 * j] : t1[2 * j - 4]);
                        x[2 * j + 1] = __uint_as_float(rb[j] & 0xffff0000u) + (j < 2 ? t0[2 * j + 1] : t1[2 * j - 3]);
                    }
#pragma unroll
                    for (int j = 0; j < 8; ++j) s += x[j] * x[j];
                    *(bf16x8*)(XB + (size_t)row * DM + c) = pack8(x);
                }
                s += __shfl_xor(s, 16, 64); s += __shfl_xor(s, 32, 64);
                if (fq == 0) atomicAdd(ssn + row, s);
            }
    }
};

struct EpiUp {
    static constexpr bool PERM = true, AFTER_DRAIN = false;
    int l;
    __device__ __forceinline__ void operator()(const f32x4 (&acc)[2][2][4][2], const Unit& u, int wr, int wc, int fr, int fq) const {
        const Params P = load_params(); unsigned char* ws = P.ws; const float* ss = (const float*)(ws + WS_SS) + (2 * l + 1) * T_ALL; bf16_t* U = (bf16_t*)(ws + WS_U);
        const int cbase = u.pn * 256 + wc * 32 + 8 * fq;
        float rs8[2][4];
#pragma unroll
        for (int ai = 0; ai < 2; ++ai)
#pragma unroll
            for (int m = 0; m < 4; ++m) rs8[ai][m] = ss[u.pm * 256 + ai * 128 + wr * 64 + m * 16 + fr];
#pragma unroll
        for (int ai = 0; ai < 2; ++ai)
#pragma unroll
            for (int m = 0; m < 4; ++m) {
                const int row = u.pm * 256 + ai * 128 + wr * 64 + m * 16 + fr;
                const float rstd = rsqrtf(rs8[ai][m] * (1.0f / 1024.0f) + EPSF);
#pragma unroll
                for (int bj = 0; bj < 2; ++bj) {
                    float v[8];
#pragma unroll
                    for (int j = 0; j < 4; ++j) {
                        float a = fmaxf(acc[ai][bj][m][0][j] * rstd, 0.f), b = fmaxf(acc[ai][bj][m][1][j] * rstd, 0.f);
                        v[j] = a * a; v[4 + j] = b * b;
                    }
                    *(bf16x8*)(U + (size_t)row * DFF + cbase + bj * 128) = pack8(v);
                }
            }
    }
};

struct WtItem { const float* W; const float* g; bf16_t* WT; int K, N, k0, n0; };
__device__ __forceinline__ WtItem wt_item(const Params& p, int it) {
    WtItem x; const int l = it / 3200; int r = it % 3200;
    if (r < 896) { x.W = p.w_in + (size_t)l * DM * NIN; x.g = p.norm1_g + l * DM; x.WT = (bf16_t*)(p.ws + WS_WIN) + (size_t)l * NIN * DM; x.K = DM; x.N = NIN; x.k0 = (r / 56) * 64; x.n0 = (r % 56) * 64; }
    else if (r < 1152) { r -= 896; x.W = p.w_out + (size_t)l * DM * DM; x.g = nullptr; x.WT = (bf16_t*)(p.ws + WS_WOUT) + (size_t)l * DM * DM; x.K = DM; x.N = DM; x.k0 = (r / 16) * 64; x.n0 = (r % 16) * 64; }
    else if (r < 2176) { r -= 1152; x.W = p.w_up + (size_t)l * DM * DFF; x.g = p.norm2_g + l * DM; x.WT = (bf16_t*)(p.ws + WS_WUP) + (size_t)l * DFF * DM; x.K = DM; x.N = DFF; x.k0 = (r / 64) * 64; x.n0 = (r % 64) * 64; }
    else { r -= 2176; x.W = p.w_down + (size_t)l * DFF * DM; x.g = nullptr; x.WT = (bf16_t*)(p.ws + WS_WDN) + (size_t)l * DM * DFF; x.K = DFF; x.N = DM; x.k0 = (r / 16) * 64; x.n0 = (r % 16) * 64; }
    return x;
}
__device__ __forceinline__ void prologue(const Params& p, unsigned char* lds) {
    int tid_l = threadIdx.x; asm volatile("" : "+v"(tid_l)); const int tid = tid_l, wid = tid >> 6, lane = tid & 63;
    float* SS = (float*)(p.ws + WS_SS);
    for (size_t i = (size_t)blockIdx.x * 512 + tid; i < 4ull * T_ALL; i += (size_t)gridDim.x * 512) SS[T_ALL + i] = 0.f;
    if (blockIdx.x == 0) { float* LB = (float*)(p.ws + WS_LB); LB[tid] = 0.f; LB[512 + tid] = 1.0f / (1.0f + __expf(p.lb_param[tid] - p.lb_param[512 + tid])); }
    const int G = gridDim.x;
    {
        float* tile = (float*)lds;
        const int kA = tid >> 4, n4 = (tid & 15) * 4;
        const int nB = tid >> 3, k8 = (tid & 7) * 8;
        int it = blockIdx.x;
        f32x4 v0, v1; float s0 = 1.f, s1 = 1.f;
        if (it < 6400) { const WtItem x = wt_item(p, it); v0 = *(const f32x4*)(x.W + (size_t)(x.k0 + kA) * x.N + x.n0 + n4); v1 = *(const f32x4*)(x.W + (size_t)(x.k0 + kA + 32) * x.N + x.n0 + n4);
            if (x.g) { s0 = x.g[x.k0 + kA]; s1 = x.g[x.k0 + kA + 32]; } }
        for (; it < 6400; it += G) {
            const WtItem x = wt_item(p, it);
#pragma unroll
            for (int j = 0; j < 4; ++j) { tile[kA * 65 + n4 + j] = v0[j] * s0; tile[(kA + 32) * 65 + n4 + j] = v1[j] * s1; }
            __syncthreads();
            if (it + G < 6400) { const WtItem y = wt_item(p, it + G); v0 = *(const f32x4*)(y.W + (size_t)(y.k0 + kA) * y.N + y.n0 + n4); v1 = *(const f32x4*)(y.W + (size_t)(y.k0 + kA + 32) * y.N + y.n0 + n4);
                s0 = 1.f; s1 = 1.f; if (y.g) { s0 = y.g[y.k0 + kA]; s1 = y.g[y.k0 + kA + 32]; } }
            float v[8];
#pragma unroll
            for (int j = 0; j < 8; ++j) v[j] = tile[(k8 + j) * 65 + nB];
            *(bf16x8*)(x.WT + (size_t)(x.n0 + nB) * x.K + x.k0 + k8) = pack8(v);
            __syncthreads();
        }
    }
    for (int it = blockIdx.x; it < T_ALL / 32; it += G) {
        const int row0 = it * 32 + wid * 4;
        f32x4 v[4][4];
#pragma unroll
        for (int rr = 0; rr < 4; ++rr) { const int row = row0 + rr; const float* xr = row >= T_P ? p.x_sample + (size_t)(row - T_P) * DM : p.x_prompt + (size_t)row * DM;
#pragma unroll
            for (int i = 0; i < 4; ++i) v[rr][i] = *(const f32x4*)(xr + lane * 4 + 256 * i); }
#pragma unroll
        for (int rr = 0; rr < 4; ++rr) { const int row = row0 + rr; bf16_t* xb = (bf16_t*)(p.ws + WS_XB) + (size_t)row * DM; float s = 0.f;
#pragma unroll
            for (int i = 0; i < 4; ++i) { const f32x4 w = v[rr][i]; s += w[0] * w[0] + w[1] * w[1] + w[2] * w[2] + w[3] * w[3]; u32x2 o; o[0] = pk2(w[0], w[1]); o[1] = pk2(w[2], w[3]); *(u32x2*)(xb + lane * 4 + 256 * i) = o; }
#pragma unroll
            for (int o = 32; o > 0; o >>= 1) s += __shfl_xor(s, o, 64);
            if (lane == 0) SS[row] = s; }
    }
}

__device__ __forceinline__ void final_norm(const Params& p) {
    int tid_l = threadIdx.x; asm volatile("" : "+v"(tid_l)); const int tid = tid_l, wid = tid >> 6, lane = tid & 63;
    const float* SS4 = (const float*)(p.ws + WS_SS) + 4 * T_ALL;
    const bf16_t* XB = (const bf16_t*)(p.ws + WS_XB);
    f32x4 g[2][2];
#pragma unroll
    for (int i = 0; i < 2; ++i) { g[i][0] = *(const f32x4*)(p.final_g + lane * 8 + 512 * i); g[i][1] = *(const f32x4*)(p.final_g + lane * 8 + 512 * i + 4); }
    for (int it = blockIdx.x; it < T_ALL / 32; it += gridDim.x) {
        const int row0 = it * 32 + wid * 4;
        u32x4v rb[4][2]; float ssv[4];
#pragma unroll
        for (int rr = 0; rr < 4; ++rr) { ssv[rr] = SS4[row0 + rr];
#pragma unroll
            for (int i = 0; i < 2; ++i) rb[rr][i] = *(const u32x4v*)(XB + (size_t)(row0 + rr) * DM + lane * 8 + 512 * i); }
#pragma unroll
        for (int rr = 0; rr < 4; ++rr) {
            float* yr = p.out + (size_t)(row0 + rr) * DM;
            const float rstd = rsqrtf(ssv[rr] * (1.0f / 1024.0f) + EPSF);
#pragma unroll
            for (int i = 0; i < 2; ++i) {
                const u32x4v w = rb[rr][i]; const f32x4 g0 = g[i][0], g1 = g[i][1];
                f32x4 y0, y1;
                y0[0] = __uint_as_float(w[0] << 16) * rstd * g0[0]; y0[1] = __uint_as_float(w[0] & 0xffff0000u) * rstd * g0[1];
                y0[2] = __uint_as_float(w[1] << 16) * rstd * g0[2]; y0[3] = __uint_as_float(w[1] & 0xffff0000u) * rstd * g0[3];
                y1[0] = __uint_as_float(w[2] << 16) * rstd * g1[0]; y1[1] = __uint_as_float(w[2] & 0xffff0000u) * rstd * g1[1];
                y1[2] = __uint_as_float(w[3] << 16) * rstd * g1[2]; y1[3] = __uint_as_float(w[3] & 0xffff0000u) * rstd * g1[3];
                *(f32x4*)(yr + lane * 8 + 512 * i) = y0; *(f32x4*)(yr + lane * 8 + 512 * i + 4) = y1;
            }
        }
    }
}

template <bool SAMPLE>
__device__ __forceinline__ void attn_item(const Params& p, int l, int item, unsigned char* lds) {
    int tid_l = threadIdx.x; asm volatile("" : "+v"(tid_l)); const int tid = tid_l, h = tid >> 6, lane = tid & 63, r = lane & 31, hh = lane >> 5;
    const float* tab = (const float*)lds + h * 256;
    float* ssq = (float*)(lds + 8448);
    constexpr int NQT = SAMPLE ? 1 : 2;
    const bf16_t* QA = (const bf16_t*)(p.ws + WS_QA); const bf16_t* KA = (const bf16_t*)(p.ws + WS_KA); const bf16_t* VT = (const bf16_t*)(p.ws + WS_VT);
    bf16_t* OB = (bf16_t*)(p.ws + WS_OB);
    int tq, b = 0, c = 0, jstart = 0, ntiles;
    if (SAMPLE) { tq = T_P + item * 16; ntiles = 17; }
    else { b = item >> 7; c = item & 127; tq = b * 8192 + c * 64; jstart = c * 64 - 512; if (jstart < 0) jstart = 0; ntiles = (c * 64 + 64 - jstart) >> 5; }
    bf16x8 qf[NQT][4];
#pragma unroll
    for (int qt = 0; qt < NQT; ++qt)
#pragma unroll
        for (int ks = 0; ks < 4; ++ks) {
            const int qrow = SAMPLE ? (r < 15 ? r : 15) : 32 * qt + r;
            qf[qt][ks] = *(const bf16x8*)(QA + (size_t)(tq + qrow) * 512 + h * 64 + 16 * ks + 8 * hh);
        }
    f32x16 o[2][NQT];
    float mrun[NQT], lsum[NQT];
#pragma unroll
    for (int qt = 0; qt < NQT; ++qt) { mrun[qt] = -1e30f; lsum[qt] = 0.f;
#pragma unroll
        for (int dt = 0; dt < 2; ++dt)
#pragma unroll
            for (int i = 0; i < 16; ++i) o[dt][qt][i] = 0.f; }
    bf16x8 kf[4], vf[2][2];
    auto load_bf = [&](int kt, bf16x8 (&kfd)[4], bf16x8 (&vfd)[2][2]) {
        const size_t krow = SAMPLE ? (size_t)(tq + (r < 15 ? r : 15)) : (size_t)(b * 8192 + jstart + kt * 32 + r);
#pragma unroll
        for (int ks = 0; ks < 4; ++ks) kfd[ks] = *(const bf16x8*)(KA + krow * 512 + h * 64 + 16 * ks + 8 * hh);
        const size_t vcol = SAMPLE ? (size_t)tq : (size_t)(b * 8192 + jstart + kt * 32);
#pragma unroll
        for (int dt = 0; dt < 2; ++dt)
#pragma unroll
            for (int ks2 = 0; ks2 < 2; ++ks2) {
                const bf16_t* vp = VT + (size_t)(512 + h * 64 + 32 * dt + r) * TPAD + vcol + 16 * ks2 + 4 * hh;
                const u32x2 lo = *(const u32x2*)vp, hi = *(const u32x2*)(vp + 8);
                u32x4v w; w[0] = lo[0]; w[1] = lo[1]; w[2] = hi[0]; w[3] = hi[1];
                vfd[dt][ks2] = __builtin_bit_cast(bf16x8, w);
            }
    };
    f32x4 kraw[8]; float vraw[32];
    auto load_cache = [&](int kt) {
        const float* kp = p.cache_k + ((size_t)(l * 32 + item) * 512 + kt * 32 + r) * 512 + h * 64 + 8 * hh;
#pragma unroll
        for (int ks = 0; ks < 4; ++ks) { kraw[2 * ks] = *(const f32x4*)(kp + 16 * ks); kraw[2 * ks + 1] = *(const f32x4*)(kp + 16 * ks + 4); }
        const float* vp = p.cache_v + ((size_t)(l * 32 + item) * 512 + kt * 32) * 512 + h * 64;
#pragma unroll
        for (int dt = 0; dt < 2; ++dt)
#pragma unroll
            for (int ks2 = 0; ks2 < 2; ++ks2)
#pragma unroll
                for (int j = 0; j < 8; ++j) { const int key = 16 * ks2 + 8 * (j >> 2) + 4 * hh + (j & 3); vraw[(dt * 2 + ks2) * 8 + j] = vp[(size_t)key * 512 + 32 * dt + r]; }
    };
    if (!SAMPLE) load_bf(0, kf, vf); else load_cache(0);
    for (int kt = 0; kt < ntiles; ++kt) {
        bf16x8 kfn[4], vfn[2][2];
        int relbase;
        const bool cache_tile = SAMPLE && kt < 16;
        if (SAMPLE) {
            if (cache_tile) {
#pragma unroll
                for (int ks = 0; ks < 4; ++ks) { const f32x4 a0 = kraw[2 * ks], a1 = kraw[2 * ks + 1]; float t8[8] = {a0[0], a0[1], a0[2], a0[3], a1[0], a1[1], a1[2], a1[3]}; kf[ks] = pack8(t8); }
#pragma unroll
                for (int dt = 0; dt < 2; ++dt)
#pragma unroll
                    for (int ks2 = 0; ks2 < 2; ++ks2) vf[dt][ks2] = pack8(vraw + (dt * 2 + ks2) * 8);
                if (kt + 1 < 16) load_cache(kt + 1);
                relbase = kt * 32 - 512;
            } else if (false) {
                const float* kp = p.cache_k + ((size_t)(l * 32 + item) * 512 + kt * 32 + r) * 512 + h * 64 + 8 * hh;
#pragma unroll
                for (int ks = 0; ks < 4; ++ks) {
                    const f32x4 a0 = *(const f32x4*)(kp + 16 * ks), a1 = *(const f32x4*)(kp + 16 * ks + 4);
                    float t8[8] = {a0[0], a0[1], a0[2], a0[3], a1[0], a1[1], a1[2], a1[3]};
                    kf[ks] = pack8(t8);
                }
                const float* vp = p.cache_v + ((size_t)(l * 32 + item) * 512 + kt * 32) * 512 + h * 64;
#pragma unroll
                for (int dt = 0; dt < 2; ++dt)
#pragma unroll
                    for (int ks2 = 0; ks2 < 2; ++ks2) {
                        float t8[8];
#pragma unroll
                        for (int j = 0; j < 8; ++j) { const int key = 16 * ks2 + 8 * (j >> 2) + 4 * hh + (j & 3); t8[j] = vp[(size_t)key * 512 + 32 * dt + r]; }
                        vf[dt][ks2] = pack8(t8);
                    }
                relbase = kt * 32 - 512;
            } else { load_bf(kt, kf, vf); relbase = 0; }
        } else {
            if (kt + 1 < ntiles) load_bf(kt + 1, kfn, vfn);
            relbase = jstart + kt * 32 - c * 64;
        }
        bf16x8 pf[NQT][2];
        const bool uni = (relbase + 31 <= -128);
        const float bias0 = tab[0];
#pragma unroll
        for (int qt = 0; qt < NQT; ++qt) {
            f32x16 st;
#pragma unroll
            for (int i = 0; i < 16; ++i) st[i] = 0.f;
#pragma unroll
            for (int ks = 0; ks < 4; ++ks) st = __builtin_amdgcn_mfma_f32_32x32x16_bf16(kf[ks], qf[qt][ks], st, 0, 0, 0);
            const int q = SAMPLE ? r : 32 * qt + r;
            float sv[16];
            if (uni) {
#pragma unroll
                for (int i = 0; i < 16; ++i) sv[i] = st[i] + bias0;
            } else {
                const float* tb = tab + (relbase - q + 192 + 4 * hh);
#pragma unroll
                for (int i = 0; i < 16; ++i) {
                    sv[i] = st[i] + tb[(i & 3) + 8 * (i >> 2)];
                    if (SAMPLE && !cache_tile && (i & 3) + 8 * (i >> 2) + 4 * hh >= 16) sv[i] = -1e30f;
                }
            }
            float mx = sv[0];
#pragma unroll
            for (int i = 1; i < 16; ++i) mx = fmaxf(mx, sv[i]);
            mx = fmaxf(mx, xor32(mx));
            if (__builtin_amdgcn_ballot_w64(mx > mrun[qt] + 8.0f) != 0ull) {
                const float mnew = fmaxf(mrun[qt], mx), alpha = __builtin_amdgcn_exp2f(mrun[qt] - mnew);
                mrun[qt] = mnew; lsum[qt] *= alpha;
#pragma unroll
                for (int dt = 0; dt < 2; ++dt)
#pragma unroll
                    for (int i = 0; i < 16; ++i) o[dt][qt][i] *= alpha;
            }
            float ps = 0.f;
#pragma unroll
            for (int i = 0; i < 16; ++i) { sv[i] = __builtin_amdgcn_exp2f(sv[i] - mrun[qt]); ps += sv[i]; }
            lsum[qt] += ps;
            pf[qt][0] = pack8(sv); pf[qt][1] = pack8(sv + 8);
        }
#pragma unroll
        for (int qt = 0; qt < NQT; ++qt)
#pragma unroll
            for (int dt = 0; dt < 2; ++dt)
#pragma unroll
                for (int ks2 = 0; ks2 < 2; ++ks2) o[dt][qt] = __builtin_amdgcn_mfma_f32_32x32x16_bf16(vf[dt][ks2], pf[qt][ks2], o[dt][qt], 0, 0, 0);
        if (!SAMPLE) {
#pragma unroll
            for (int ks = 0; ks < 4; ++ks) kf[ks] = kfn[ks];
#pragma unroll
            for (int dt = 0; dt < 2; ++dt)
#pragma unroll
                for (int ks2 = 0; ks2 < 2; ++ks2) vf[dt][ks2] = vfn[dt][ks2];
        }
    }
#pragma unroll
    for (int qt = 0; qt < NQT; ++qt) {
        const float lt = lsum[qt] + xor32(lsum[qt]), inv = 1.0f / lt;
        float sq = 0.f;
#pragma unroll
        for (int dt = 0; dt < 2; ++dt)
#pragma unroll
            for (int i = 0; i < 16; ++i) { const float v = o[dt][qt][i] * inv; o[dt][qt][i] = v; sq += v * v; }
        sq += xor32(sq);
        if (hh == 0) ssq[h * 64 + 32 * qt + r] = sq;
    }
    __syncthreads();
    const float* ga = p.att_norm_g + l * 512 + h * 64;
    f32x4 gav[2][4];
#pragma unroll
    for (int dt = 0; dt < 2; ++dt)
#pragma unroll
        for (int ig = 0; ig < 4; ++ig) gav[dt][ig] = *(const f32x4*)(ga + 32 * dt + 8 * ig + 4 * hh);
#pragma unroll
    for (int qt = 0; qt < NQT; ++qt) {
        const int q = 32 * qt + r;
        float tot = 0.f;
#pragma unroll
        for (int h2 = 0; h2 < 8; ++h2) tot += ssq[h2 * 64 + q];
        const float rstd = rsqrtf(tot * (1.0f / 512.0f) + EPSF);
        if (!SAMPLE || r < 16) {
#pragma unroll
            for (int dt = 0; dt < 2; ++dt)
#pragma unroll
                for (int ig = 0; ig < 4; ++ig) {
                    const int d0 = 32 * dt + 8 * ig + 4 * hh;
                    const f32x4 g = gav[dt][ig];
                    u32x2 w; w[0] = pk2(o[dt][qt][4 * ig] * rstd * g[0], o[dt][qt][4 * ig + 1] * rstd * g[1]); w[1] = pk2(o[dt][qt][4 * ig + 2] * rstd * g[2], o[dt][qt][4 * ig + 3] * rstd * g[3]);
                    *(u32x2*)(OB + (size_t)(tq + q) * DM + 512 + h * 64 + d0) = w;
                }
        }
    }
    __syncthreads();
}

__device__ __forceinline__ void attn_prompt_item(const Params& p, int l, int item, unsigned char* lds) {
    int tid_l = threadIdx.x; asm volatile("" : "+v"(tid_l)); const int tid = tid_l, h = tid >> 6, lane = tid & 63, r = lane & 31, hh = lane >> 5;
    const float* tab = (const float*)lds + h * 256;
    float* ssq = (float*)(lds + 8448);
    unsigned char* KT = lds + 16384 + h * 16384; unsigned char* VTl = KT + 4096; unsigned char* QT = KT + 8192;
    const bf16_t* QA = (const bf16_t*)(p.ws + WS_QA); const bf16_t* KA = (const bf16_t*)(p.ws + WS_KA); const bf16_t* VT = (const bf16_t*)(p.ws + WS_VT);
    bf16_t* OB = (bf16_t*)(p.ws + WS_OB);
    const int b = item >> 7, c = item & 127, tq = b * 8192 + c * 64;
    int jstart = c * 64 - 512; if (jstart < 0) jstart = 0;
    const int ntiles = (c * 64 + 64 - jstart) >> 5;
    {
#pragma unroll
        for (int j = 0; j < 8; ++j) {
            const int q = 8 * j + (lane >> 3), ch = lane & 7;
            *(u32x4v*)(QT + q * 128 + ((ch ^ ((q >> 1) & 7)) * 16)) = *(const u32x4v*)(QA + (size_t)(tq + q) * 512 + h * 64 + ch * 8);
        }
    }
    f32x16 o[2][2];
    float mrun[2], lsum[2];
#pragma unroll
    for (int qt = 0; qt < 2; ++qt) { mrun[qt] = -1e30f; lsum[qt] = 0.f;
#pragma unroll
        for (int dt = 0; dt < 2; ++dt)
#pragma unroll
            for (int i = 0; i < 16; ++i) o[dt][qt][i] = 0.f; }
    const int kkey = lane >> 3, kch = lane & 7;
    const int vd = lane >> 2, vc = lane & 3;
    const bf16_t* kg = KA + (size_t)(b * 8192 + jstart + kkey) * 512 + h * 64 + kch * 8;
    const bf16_t* vg = VT + (size_t)(512 + h * 64 + vd) * TPAD + (size_t)(b * 8192 + jstart) + vc * 8;
    u32x4v kraw[4], vraw[4];
#pragma unroll
    for (int j = 0; j < 4; ++j) { kraw[j] = *(const u32x4v*)(kg + (size_t)(8 * j) * 512); vraw[j] = *(const u32x4v*)(vg + (size_t)(16 * j) * TPAD); }
    const float bias0 = tab[0];
    for (int kt = 0; kt < ntiles; ++kt) {
#pragma unroll
        for (int j = 0; j < 4; ++j) {
            const int key = 8 * j + kkey;
            *(u32x4v*)(KT + key * 128 + ((kch ^ ((key >> 1) & 7)) * 16)) = kraw[j];
            const int d = 16 * j + vd, g = (d >> 2) & 7;
            u32x2 lo, hi; lo[0] = vraw[j][0]; lo[1] = vraw[j][1]; hi[0] = vraw[j][2]; hi[1] = vraw[j][3];
            *(u32x2*)(VTl + d * 64 + (((2 * vc) ^ g) * 8)) = lo;
            *(u32x2*)(VTl + d * 64 + (((2 * vc + 1) ^ g) * 8)) = hi;
        }
        if (kt + 1 < ntiles) {
#pragma unroll
            for (int j = 0; j < 4; ++j) { kraw[j] = *(const u32x4v*)(kg + (size_t)((kt + 1) * 32 + 8 * j) * 512); vraw[j] = *(const u32x4v*)(vg + (size_t)(16 * j) * TPAD + (kt + 1) * 32); }
        }
        const int relbase = jstart + kt * 32 - c * 64;
        const bool uni = (relbase + 31 <= -128);
#pragma unroll
        for (int qt = 0; qt < 2; ++qt) {
            asm volatile("" ::: "memory");
            f32x16 st;
#pragma unroll
            for (int i = 0; i < 16; ++i) st[i] = 0.f;
#pragma unroll
            for (int ks = 0; ks < 4; ++ks) st = __builtin_amdgcn_mfma_f32_32x32x16_bf16(*(const bf16x8*)(KT + r * 128 + (((2 * ks + hh) ^ ((r >> 1) & 7)) * 16)), *(const bf16x8*)(QT + (32 * qt + r) * 128 + (((2 * ks + hh) ^ (((32 * qt + r) >> 1) & 7)) * 16)), st, 0, 0, 0);
            const int q = 32 * qt + r;
            float sv[16];
            if (uni) {
#pragma unroll
                for (int i = 0; i < 16; ++i) sv[i] = st[i] + bias0;
            } else {
                const float* tb = tab + (relbase - q + 192 + 4 * hh);
#pragma unroll
                for (int i = 0; i < 16; ++i) sv[i] = st[i] + tb[(i & 3) + 8 * (i >> 2)];
            }
            float mx = sv[0];
#pragma unroll
            for (int i = 1; i < 16; ++i) mx = fmaxf(mx, sv[i]);
            mx = fmaxf(mx, xor32(mx));
            if (__builtin_amdgcn_ballot_w64(mx > mrun[qt] + 8.0f) != 0ull) {
                const float mnew = fmaxf(mrun[qt], mx), alpha = __builtin_amdgcn_exp2f(mrun[qt] - mnew);
                mrun[qt] = mnew; lsum[qt] *= alpha;
#pragma unroll
                for (int dt = 0; dt < 2; ++dt)
#pragma unroll
                    for (int i = 0; i < 16; ++i) o[dt][qt][i] *= alpha;
            }
            float ps = 0.f;
#pragma unroll
            for (int i = 0; i < 16; ++i) { sv[i] = __builtin_amdgcn_exp2f(sv[i] - mrun[qt]); ps += sv[i]; }
            lsum[qt] += ps;
            bf16x8 pf[2];
            pf[0] = pack8(sv); pf[1] = pack8(sv + 8);
#pragma unroll
            for (int dt = 0; dt < 2; ++dt)
#pragma unroll
                for (int ks2 = 0; ks2 < 2; ++ks2) {
                    const int d = 32 * dt + r, g = (d >> 2) & 7, u = 4 * ks2 + hh;
                    const u32x2 lo = *(const u32x2*)(VTl + d * 64 + ((u ^ g) * 8)), hi = *(const u32x2*)(VTl + d * 64 + (((u + 2) ^ g) * 8));
                    u32x4v w; w[0] = lo[0]; w[1] = lo[1]; w[2] = hi[0]; w[3] = hi[1];
                    o[dt][qt] = __builtin_amdgcn_mfma_f32_32x32x16_bf16(__builtin_bit_cast(bf16x8, w), pf[ks2], o[dt][qt], 0, 0, 0);
                }
        }
    }
#pragma unroll
    for (int qt = 0; qt < 2; ++qt) {
        const float lt = lsum[qt] + xor32(lsum[qt]), inv = 1.0f / lt;
        float sq = 0.f;
#pragma unroll
        for (int dt = 0; dt < 2; ++dt)
#pragma unroll
            for (int i = 0; i < 16; ++i) { const float v = o[dt][qt][i] * inv; o[dt][qt][i] = v; sq += v * v; }
        sq += xor32(sq);
        if (hh == 0) ssq[h * 64 + 32 * qt + r] = sq;
    }
    __syncthreads();
    const float* ga = p.att_norm_g + l * 512 + h * 64;
    f32x4 gav[2][4];
#pragma unroll
    for (int dt = 0; dt < 2; ++dt)
#pragma unroll
        for (int ig = 0; ig < 4; ++ig) gav[dt][ig] = *(const f32x4*)(ga + 32 * dt + 8 * ig + 4 * hh);
#pragma unroll
    for (int qt = 0; qt < 2; ++qt) {
        const int q = 32 * qt + r;
        float tot = 0.f;
#pragma unroll
        for (int h2 = 0; h2 < 8; ++h2) tot += ssq[h2 * 64 + q];
        const float rstd = rsqrtf(tot * (1.0f / 512.0f) + EPSF);
#pragma unroll
        for (int dt = 0; dt < 2; ++dt)
#pragma unroll
            for (int ig = 0; ig < 4; ++ig) {
                const int d0 = 32 * dt + 8 * ig + 4 * hh;
                const f32x4 g = gav[dt][ig];
                u32x2 w; w[0] = pk2(o[dt][qt][4 * ig] * rstd * g[0], o[dt][qt][4 * ig + 1] * rstd * g[1]); w[1] = pk2(o[dt][qt][4 * ig + 2] * rstd * g[2], o[dt][qt][4 * ig + 3] * rstd * g[3]);
                *(u32x2*)(OB + (size_t)(tq + q) * DM + 512 + h * 64 + d0) = w;
            }
    }
    __syncthreads();
}

struct HItem { int tb, nt, h; };
__device__ __forceinline__ HItem hitem(int it) {
    HItem x;
    if (it < 2048) { const int b = it >> 9, c = it & 127; x.h = (it >> 7) & 3; x.tb = b * 8192 + c * 64; x.nt = 64; }
    else { const int j = it - 2048; x.h = j & 3; x.tb = T_P + (j >> 2) * 16; x.nt = 16; }
    return x;
}
__device__ __forceinline__ int passA_index(int bx, int G, int j) {
    if (G != 256) { const int it = bx + G * j; return it < 2176 ? it : -1; }
    const int nA = bx >= 32 ? 8 : 0;
    if (j < nA) return (bx - 32) + 224 * j;
    if (j == nA) return 1792 + bx;
    if (j == nA + 1 && bx < 128) return 2048 + bx;
    return -1;
}
__device__ __forceinline__ void hgrn_passA_phase(const Params& p, int l, unsigned char* lds) {
    int tid_l = threadIdx.x; asm volatile("" : "+v"(tid_l)); const int tid = tid_l, wid = tid >> 6, lane = tid & 63, r = lane & 31, hh = lane >> 5, k = tid & 127, seg = tid >> 7;
    const int bx = blockIdx.x, G = gridDim.x;
    float* tot = (float*)(lds + 16384); bf16_t* khT = (bf16_t*)(lds + 16384 + 2048); float* dl = (float*)(lds + 16384 + 2048 + 18432);
    float* LF = (float*)(p.ws + WS_LF); bf16_t* LFb = (bf16_t*)(p.ws + WS_LF); const bf16_t* VT = (const bf16_t*)(p.ws + WS_VT); bf16_t* QH = (bf16_t*)(p.ws + WS_QH);
    float lf[16]; bf16_t qr[16];
    unsigned* qctr = (unsigned*)(p.ws + WS_BAR) + 3700 + l;
    volatile PG8_LAS int* qw = (volatile PG8_LAS int*)((PG8_LAS unsigned char*)lds + 16384 + 2048 + 18432 + 512);
    bf16_t* Q1s = (bf16_t*)(lds + 40960); bf16_t* Q2s = (bf16_t*)(lds + 57344); bf16_t* K2s = (bf16_t*)(lds + 73728);
    (void)bx; (void)G;
    if (tid == 0) { const unsigned q0 = __hip_atomic_fetch_add(qctr, 1u, __ATOMIC_RELAXED, __HIP_MEMORY_SCOPE_AGENT), q1 = __hip_atomic_fetch_add(qctr, 1u, __ATOMIC_RELAXED, __HIP_MEMORY_SCOPE_AGENT); qw[0] = (int)q0; qw[1] = (int)q1; }
    __syncthreads();
    auto qmap = [](int q) { return q >= 2176 ? -1 : (q < 128 ? 2048 + q : q - 128); };
    int it = qmap(qw[0]), itn = qmap(qw[1]);
    if (it >= 0) { const HItem X = hitem(it);
#pragma unroll
        for (int j = 0; j < 16; ++j) { const int t = seg * 16 + j; const bool ok = t < X.nt; lf[j] = ok ? LF[(size_t)(X.tb + t) * 512 + X.h * 128 + k] : 0.f; qr[j] = ok ? QH[(size_t)(X.tb + t) * 512 + X.h * 128 + k] : (bf16_t)0; } }
    while (it >= 0) {
        const HItem X = hitem(it);
        unsigned qnn = 0u; if (tid == 0) qnn = __hip_atomic_fetch_add(qctr, 1u, __ATOMIC_RELAXED, __HIP_MEMORY_SCOPE_AGENT);
        bf16_t* ST = (bf16_t*)(p.ws + WS_ST) + (size_t)it * 16384; float* D = (float*)(p.ws + WS_D) + (size_t)it * 128;
        const int kt = wid & 3, vt0 = 2 * (wid >> 2);
        bf16x8 vfr[4][2];
#pragma unroll
        for (int ks = 0; ks < 4; ++ks)
#pragma unroll
            for (int e = 0; e < 2; ++e) vfr[ks][e] = *(const bf16x8*)(VT + (size_t)(X.h * 128 + (vt0 + e) * 32 + r) * TPAD + X.tb + 16 * ks + 8 * hh);
        float bb[16];
        { float run = 0.f;
#pragma unroll
          for (int j = 0; j < 16; ++j) { run += lf[j]; bb[j] = run; }
          tot[seg * 128 + k] = run; }
        __syncthreads();
        const float t0 = tot[k], t1 = tot[128 + k], t2 = tot[256 + k], t3 = tot[384 + k];
        const float off = (seg > 0 ? t0 : 0.f) + (seg > 1 ? t1 : 0.f) + (seg > 2 ? t2 : 0.f), blast = t0 + t1 + t2 + t3, bmid = t0 + t1;
        {
            float kh[16];
#pragma unroll
            for (int j = 0; j < 16; ++j) {
                const int t = seg * 16 + j;
                const float bj = bb[j] + off, kk = 1.0f - __expf(lf[j]), q = bf2f(qr[j]);
                kh[j] = kk * __expf(blast - bj);
                Q1s[t * 128 + k] = f2bf(q * __expf(bj));
                Q2s[t * 128 + k] = f2bf(q * __expf(bj - bmid));
                K2s[t * 128 + k] = f2bf(kk * __expf(bmid - bj));
            }
            bf16_t* d = khT + k * 72 + seg * 16;
            *(bf16x8*)d = pack8(kh); *(bf16x8*)(d + 8) = pack8(kh + 8);
            if (seg == 0) { const float dk = __expf(blast); D[k] = dk; dl[k] = dk; }
        }
        if (itn >= 0) { const HItem Y = hitem(itn);
#pragma unroll
            for (int j = 0; j < 16; ++j) { const int t = seg * 16 + j; const bool ok = t < Y.nt; lf[j] = ok ? LF[(size_t)(Y.tb + t) * 512 + Y.h * 128 + k] : 0.f; qr[j] = ok ? QH[(size_t)(Y.tb + t) * 512 + Y.h * 128 + k] : (bf16_t)0; } }
        __syncthreads();
#pragma unroll
        for (int i = 0; i < 2; ++i) {
            const int c = tid + 512 * i, t = c >> 4, kc = (c & 15) * 8;
            if (t < X.nt) {
                const size_t row = (size_t)(X.tb + t);
                *(u32x4v*)(QH + row * 512 + X.h * 128 + kc) = *(const u32x4v*)(Q1s + t * 128 + kc);
                *(u32x4v*)(LFb + row * 1024 + X.h * 256 + kc) = *(const u32x4v*)(Q2s + t * 128 + kc);
                *(u32x4v*)(LFb + row * 1024 + X.h * 256 + 128 + kc) = *(const u32x4v*)(K2s + t * 128 + kc);
            }
        }
        {
            f32x16 acc[2];
#pragma unroll
            for (int e = 0; e < 2; ++e)
#pragma unroll
                for (int i = 0; i < 16; ++i) acc[e][i] = 0.f;
#pragma unroll
            for (int ks = 0; ks < 4; ++ks) {
                const bf16x8 a = *(const bf16x8*)(khT + (kt * 32 + r) * 72 + 16 * ks + 8 * hh);
#pragma unroll
                for (int e = 0; e < 2; ++e) {
                    acc[e] = __builtin_amdgcn_mfma_f32_32x32x16_bf16(a, vfr[ks][e], acc[e], 0, 0, 0);
                }
            }
            if (it >= 2048) {
                const int sj = it - 2048;
                const float* s0p = p.state_hgrn + ((size_t)l * 128 + sj) * 16384; float* fin = p.out + O_SS + ((size_t)l * 128 + sj) * 16384;
#pragma unroll
                for (int e = 0; e < 2; ++e) {
                    const int v = (vt0 + e) * 32 + r;
                    float s0v[16];
#pragma unroll
                    for (int i = 0; i < 16; ++i) s0v[i] = s0p[(size_t)(kt * 32 + (i & 3) + 8 * (i >> 2) + 4 * hh) * 128 + v];
#pragma unroll
                    for (int i = 0; i < 16; ++i) { const int kk = kt * 32 + (i & 3) + 8 * (i >> 2) + 4 * hh; fin[(size_t)kk * 128 + v] = dl[kk] * s0v[i] + acc[e][i]; }
#pragma unroll
                    for (int ig = 0; ig < 4; ++ig) {
                        u32x2 w; w[0] = pk2(s0v[4 * ig], s0v[4 * ig + 1]); w[1] = pk2(s0v[4 * ig + 2], s0v[4 * ig + 3]);
                        *(u32x2*)(ST + (size_t)v * 128 + kt * 32 + 8 * ig + 4 * hh) = w;
                    }
                }
            } else {
#pragma unroll
            for (int e = 0; e < 2; ++e)
#pragma unroll
                for (int ig = 0; ig < 4; ++ig) {
                    u32x2 w; w[0] = pk2(acc[e][4 * ig], acc[e][4 * ig + 1]); w[1] = pk2(acc[e][4 * ig + 2], acc[e][4 * ig + 3]);
                    *(u32x2*)(ST + (size_t)((vt0 + e) * 32 + r) * 128 + kt * 32 + 8 * ig + 4 * hh) = w;
                }
            }
        }
        if (tid == 0) qw[0] = (int)qnn;
        __syncthreads();
        it = itn; itn = qmap(qw[0]);
    }
}

__device__ __forceinline__ void hgrn_scan(const Params& p, int l) {
    int tid_l = threadIdx.x; asm volatile("" : "+v"(tid_l)); const int tid = tid_l;
    typedef float f32x2v __attribute__((ext_vector_type(2)));
    for (int u = blockIdx.x; u < 256; u += gridDim.x) {
        const int seq = u >> 4, sub = u & 15, item0 = seq * 128;
        float* fin = p.out + O_SP + ((size_t)l * 16 + seq) * 16384;
        const int e = sub * 1024 + tid * 2, v = e >> 7, k = e & 127;
        float S0 = 0.f, S1 = 0.f;
        unsigned* stp = (unsigned*)((bf16_t*)(p.ws + WS_ST) + (size_t)item0 * 16384 + e);
        const float* dp = (const float*)(p.ws + WS_D) + (size_t)item0 * 128 + k;
        for (int c0 = 0; c0 < 128; c0 += 32) {
            unsigned Lr[32]; f32x2v dd[32];
#pragma unroll
            for (int j = 0; j < 32; ++j) { Lr[j] = stp[(size_t)(c0 + j) * 8192]; dd[j] = *(const f32x2v*)(dp + (size_t)(c0 + j) * 128); }
#pragma unroll
            for (int j = 0; j < 32; ++j) {
                stp[(size_t)(c0 + j) * 8192] = pk2(S0, S1);
                S0 = dd[j][0] * S0 + __uint_as_float(Lr[j] << 16); S1 = dd[j][1] * S1 + __uint_as_float(Lr[j] & 0xffff0000u);
            }
        }
        fin[k * 128 + v] = S0; fin[(k + 1) * 128 + v] = S1;
    }
}

__device__ __forceinline__ void hgrn_passC_phase(const Params& p, int l) {
    int tid_l = threadIdx.x; asm volatile("" : "+v"(tid_l)); const int tid = tid_l, wid = tid >> 6, lane = tid & 63, r = lane & 31, hh = lane >> 5;
    const bf16_t* LFb = (const bf16_t*)(p.ws + WS_LF); const bf16_t* VT = (const bf16_t*)(p.ws + WS_VT);
    const bf16_t* QH = (const bf16_t*)(p.ws + WS_QH); const bf16_t* GH = (const bf16_t*)(p.ws + WS_GH);
    bf16_t* OB = (bf16_t*)(p.ws + WS_OB);
    const int nw = gridDim.x * 8, gw = blockIdx.x * 8 + wid;
    const int nprompt = (4096 - gw + nw - 1) / nw, nextra = (nw == 2048 && (gw & 15) == 0) ? 1 : (nw == 2048 ? 0 : (128 - gw + nw - 1) / nw);
    for (int ti = 0; ti < nprompt + nextra; ++ti) {
        int it, tt;
        if (ti < nprompt) { const int task = gw + ti * nw; it = task >> 1; tt = task & 1; }
        else { it = 2048 + (nw == 2048 ? (gw >> 4) : gw + (ti - nprompt) * nw); tt = 0; }
        const HItem X = hitem(it);
        const bf16_t* ST = (const bf16_t*)(p.ws + WS_ST) + (size_t)it * 16384;
        const int t = tt * 32 + r;
        const size_t trow = (size_t)(X.tb + t);
        bf16x8 pf[2][2];
        {
            bf16x8 q2f[8];
#pragma unroll
            for (int ks = 0; ks < 8; ++ks) q2f[ks] = *(const bf16x8*)(LFb + trow * 1024 + X.h * 256 + 16 * ks + 8 * hh);
#pragma unroll
            for (int st = 0; st < 2; ++st) {
                if (st <= tt) {
                    f32x16 xs;
#pragma unroll
                    for (int i = 0; i < 16; ++i) xs[i] = 0.f;
                    const bf16_t* kp = LFb + (size_t)(X.tb + st * 32 + r) * 1024 + X.h * 256 + 128 + 8 * hh;
#pragma unroll
                    for (int ks = 0; ks < 8; ++ks) xs = __builtin_amdgcn_mfma_f32_32x32x16_bf16(*(const bf16x8*)(kp + 16 * ks), q2f[ks], xs, 0, 0, 0);
                    float pv[16];
#pragma unroll
                    for (int i = 0; i < 16; ++i) { const int s = st * 32 + (i & 3) + 8 * (i >> 2) + 4 * hh; pv[i] = (s <= t) ? xs[i] : 0.f; }
                    pf[st][0] = pack8(pv); pf[st][1] = pack8(pv + 8);
                }
            }
        }
        bf16x8 q1f[8];
#pragma unroll
        for (int ks = 0; ks < 8; ++ks) q1f[ks] = *(const bf16x8*)(QH + trow * 512 + X.h * 128 + 16 * ks + 8 * hh);
        f32x16 acc[4];
#pragma unroll
        for (int vt = 0; vt < 4; ++vt) {
#pragma unroll
            for (int i = 0; i < 16; ++i) acc[vt][i] = 0.f;
            const bf16_t* sp = ST + (size_t)(vt * 32 + r) * 128 + 8 * hh;
#pragma unroll
            for (int ks = 0; ks < 8; ++ks) acc[vt] = __builtin_amdgcn_mfma_f32_32x32x16_bf16(*(const bf16x8*)(sp + 16 * ks), q1f[ks], acc[vt], 0, 0, 0);
#pragma unroll
            for (int st = 0; st < 2; ++st) {
                if (st <= tt) {
#pragma unroll
                    for (int ks2 = 0; ks2 < 2; ++ks2) {
                        const bf16_t* vp = VT + (size_t)(X.h * 128 + vt * 32 + r) * TPAD + X.tb + st * 32 + 16 * ks2 + 4 * hh;
                        const u32x2 lo = *(const u32x2*)vp, hi = *(const u32x2*)(vp + 8);
                        u32x4v w; w[0] = lo[0]; w[1] = lo[1]; w[2] = hi[0]; w[3] = hi[1];
                        acc[vt] = __builtin_amdgcn_mfma_f32_32x32x16_bf16(__builtin_bit_cast(bf16x8, w), pf[st][ks2], acc[vt], 0, 0, 0);
                    }
                }
            }
        }
        float sq = 0.f;
#pragma unroll
        for (int vt = 0; vt < 4; ++vt)
#pragma unroll
            for (int i = 0; i < 16; ++i) sq += acc[vt][i] * acc[vt][i];
        sq += xor32(sq);
        const float rstd = rsqrtf(sq * (1.0f / 128.0f) + EPSF);
        if (t < X.nt) {
            const float* gh = p.hg_norm_g + l * 512 + X.h * 128;
            f32x4 gv[4][4]; u32x2 ggv[4][4];
#pragma unroll
            for (int vt = 0; vt < 4; ++vt)
#pragma unroll
                for (int ig = 0; ig < 4; ++ig) { const int v0 = vt * 32 + 8 * ig + 4 * hh; gv[vt][ig] = *(const f32x4*)(gh + v0); ggv[vt][ig] = *(const u32x2*)(GH + trow * 512 + X.h * 128 + v0); }
#pragma unroll
            for (int vt = 0; vt < 4; ++vt)
#pragma unroll
                for (int ig = 0; ig < 4; ++ig) {
                    const int v0 = vt * 32 + 8 * ig + 4 * hh;
                    const f32x4 g = gv[vt][ig];
                    const u32x2 gg = ggv[vt][ig];
                    const float s0 = __uint_as_float(gg[0] << 16), s1 = __uint_as_float(gg[0] & 0xffff0000u), s2 = __uint_as_float(gg[1] << 16), s3 = __uint_as_float(gg[1] & 0xffff0000u);
                    u32x2 w; w[0] = pk2(acc[vt][4 * ig] * rstd * g[0] * s0, acc[vt][4 * ig + 1] * rstd * g[1] * s1); w[1] = pk2(acc[vt][4 * ig + 2] * rstd * g[2] * s2, acc[vt][4 * ig + 3] * rstd * g[3] * s3);
                    *(u32x2*)(OB + trow * DM + X.h * 128 + v0) = w;
                }
        }
    }
}

__device__ __forceinline__ int lbid() { int x = blockIdx.x; asm volatile("" : "+s"(x)); return x; }
__device__ __forceinline__ int lgrid() { int x = gridDim.x; asm volatile("" : "+s"(x)); return x; }
__device__ __forceinline__ int lreps(int x) { asm volatile("" : "+s"(x)); return x; }
#ifndef STAG_TICKS
#define STAG_TICKS 400
#endif
__device__ __forceinline__ void stagger() {
    const unsigned g = ((unsigned)lbid() >> 3) & 3u;
    if (STAG_TICKS > 0 && g) { const unsigned long long t0 = __builtin_amdgcn_s_memrealtime(); while (__builtin_amdgcn_s_memrealtime() - t0 < (unsigned long long)(g * STAG_TICKS)) __builtin_amdgcn_s_sleep(8); }
}
#define XB_TMO      128
#define XB_XCNT(j)  (256  + 64 * (j))
#define XB_XSUB(j)  (1280 + 64 * (j))
#define XB_XGEN(j)  (2304 + 64 * (j))
#define XB_TOP      3328
#define XB_TOPGEN   3392
#define XCD_BAR_WORDS 3456
#define XB_SPIN_CAP (1u << 18)
#define LAS __attribute__((address_space(3)))

__device__ __forceinline__ unsigned xb_ld(unsigned* p)              { return __hip_atomic_load(p, __ATOMIC_RELAXED, __HIP_MEMORY_SCOPE_AGENT); }
__device__ __forceinline__ unsigned xb_add(unsigned* p, unsigned v) { return __hip_atomic_fetch_add(p, v, __ATOMIC_RELAXED, __HIP_MEMORY_SCOPE_AGENT); }
__device__ __forceinline__ unsigned xb_xcc_id() { return (unsigned)__builtin_amdgcn_s_getreg((3 << 11) | 20) & 0xFu; }
#define XB_SPIN(cond, bar) do { unsigned _sp = 0; while (cond) { __builtin_amdgcn_s_sleep(1); \
    if ((++_sp & 255u) == 0u) { if (xb_ld(&(bar)[XB_TMO])) break; if (_sp > XB_SPIN_CAP) { atomicAdd(&(bar)[XB_TMO], 1u); break; } } } } while (0)

struct XcdBarrier {
    unsigned* bar; unsigned x;
    volatile LAS unsigned* st;
};

__device__ __forceinline__ XcdBarrier xcd_barrier_post(unsigned* bar, volatile LAS unsigned* st) {
    XcdBarrier b; b.bar = bar; b.x = xb_xcc_id(); b.st = st;
    if (threadIdx.x == 0) (void)xb_add(&bar[XB_XCNT(b.x)], 1u);
    return b;
}
__device__ __forceinline__ void xcd_barrier_complete(unsigned* bar, unsigned x, unsigned& nloc, unsigned& nx) {
    const unsigned G = gridDim.x * gridDim.y * gridDim.z;
    unsigned sum, cnt, mine, sp = 0u;
    for (;;) {
        sum = 0u; cnt = 0u; mine = 0u;
#pragma unroll
        for (unsigned j = 0; j < 16; ++j) { const unsigned c = xb_ld(&bar[XB_XCNT(j)]); sum += c; cnt += (c > 0u) ? 1u : 0u; mine = (j == x) ? c : mine; }
        if (sum == G) break;
        __builtin_amdgcn_s_sleep(1);
        if ((++sp & 255u) == 0u) { if (xb_ld(&bar[XB_TMO])) break; if (sp > XB_SPIN_CAP) { atomicAdd(&bar[XB_TMO], 1u); break; } }
    }
    nloc = mine > 0u ? mine : 1u; nx = cnt > 0u ? cnt : 1u;
}

__device__ __forceinline__ void xcd_barrier(const XcdBarrier& b) {
    asm volatile("s_waitcnt vmcnt(0)" ::: "memory");
    __syncthreads();
    int t0_ = threadIdx.x; asm volatile("" : "+v"(t0_));
    if (t0_ == 0) {
        unsigned* bar = b.bar;
        __builtin_amdgcn_s_waitcnt(0);
        unsigned nloc = b.st[0], nx = b.st[1];
        if (nloc == 0u) { xcd_barrier_complete(bar, b.x, nloc, nx); b.st[0] = nloc; b.st[1] = nx; }
        const unsigned old = xb_add(&bar[XB_XSUB(b.x)], 1u);
        const unsigned gen = old / nloc;
        if (old + 1u == (gen + 1u) * nloc) {
            __builtin_amdgcn_fence(__ATOMIC_RELEASE, "agent");
            asm volatile("s_waitcnt vmcnt(0)" ::: "memory");
            const unsigned og = xb_add(&bar[XB_TOP], 1u);
            const unsigned tg = og / nx;
            if (og + 1u == (tg + 1u) * nx) xb_add(&bar[XB_TOPGEN], 1u);
            else XB_SPIN(xb_ld(&bar[XB_TOPGEN]) == tg, bar);
            __builtin_amdgcn_fence(__ATOMIC_ACQUIRE, "agent");
            xb_add(&bar[XB_XGEN(b.x)], 1u);
            asm volatile("s_waitcnt vmcnt(0)" ::: "memory");
        } else {
            XB_SPIN(xb_ld(&bar[XB_XGEN(b.x)]) == gen, bar);
            __builtin_amdgcn_fence(__ATOMIC_ACQUIRE, "agent");
            asm volatile("s_waitcnt vmcnt(0)" ::: "memory");
        }
    }
    __syncthreads();
}


__device__ __forceinline__ void my_grid_sync(unsigned* bar, unsigned target) {
    int t = threadIdx.x; asm volatile("" : "+v"(t));
    asm volatile("s_waitcnt vmcnt(0)" ::: "memory");
    __syncthreads();
    if (t == 0) {
        __builtin_amdgcn_fence(__ATOMIC_RELEASE, "agent");
        asm volatile("s_waitcnt vmcnt(0)" ::: "memory");
        __hip_atomic_fetch_add(bar, 1u, __ATOMIC_RELAXED, __HIP_MEMORY_SCOPE_AGENT);
        while (__hip_atomic_load(bar, __ATOMIC_RELAXED, __HIP_MEMORY_SCOPE_AGENT) < target) __builtin_amdgcn_s_sleep(1);
        __builtin_amdgcn_fence(__ATOMIC_ACQUIRE, "agent");
        asm volatile("s_waitcnt vmcnt(0)" ::: "memory");
    }
    __syncthreads();
}
#ifndef ONLY
#define ONLY -1
#endif
#ifndef DUPP
#define DUPP -1
#endif
#define REPS(id) _Pragma("nounroll") for (int rep_ = 0, nrep_ = lreps(DUPP == (id) ? 2 : 1); rep_ < nrep_; ++rep_)
__global__ void __launch_bounds__(512, 2) hymba_fwd(Params p_unused) {
    extern __shared__ __attribute__((aligned(16))) unsigned char lds[];
    int lo, hi; { KP kp = kparams(); lo = kp->ph_lo; hi = kp->ph_hi; }
#ifndef SKIPP
#define SKIPP -2
#endif
#define PHID(k) ((k) == 0 ? 0 : (k) == 15 ? 15 : ((k) - 1) % 7 + 1)
#define IN(k) (lo <= (k) && (k) < hi && (ONLY < 0 || ONLY == PHID(k)) && SKIPP != PHID(k))
    unsigned nsync = 0;
    volatile LAS unsigned* xb_st = (volatile LAS unsigned*)((LAS unsigned char*)lds + pg8::STAGE_BYTES + 8 * 2560);
    if (threadIdx.x == 0) { xb_st[0] = 0u; xb_st[1] = 0u; }
    __syncthreads();
    XcdBarrier xbar = xcd_barrier_post((unsigned*)(load_params().ws + WS_BAR), xb_st);
#define SEAM(k) do { if (IN(k) && IN((k) + 1)) { xcd_barrier(xbar); } } while (0)
    if (IN(0)) REPS(0) { const Params p = load_params(); prologue(p, lds); }
    if (lo < 0) cg::this_grid().sync();
    SEAM(0);
    for (int l = 0; l < 2; ++l) {
        const int base = 1 + 7 * l;
        if (IN(base)) REPS(1) {
            const Params p = load_params(); unsigned char* ws = p.ws;
            pg8::Gemm g{(const bf16_t*)(ws + WS_XB), (const bf16_t*)(ws + WS_WIN) + (size_t)l * NIN * DM, T_ALL, NIN, DM, DM};
            pg8::StaticOrder S; S.init(T_ALL, NIN, lgrid(), lbid());
            EpiIn E{l, (PG8_LAS unsigned char*)lds + pg8::STAGE_BYTES, rep_};
            pg8::gemm_phase<EpiIn, pg8::StaticOrder, false>((PG8_LAS unsigned char*)lds, g, S, E, nullptr);
        }
        SEAM(base);
        if (IN(base + 1)) {
            const Params p = load_params(); const int G = gridDim.x, bx = blockIdx.x;
            __syncthreads();
            for (int i = threadIdx.x; i < 8 * 256; i += 512) { const int hh_ = i / 256; int idx = i % 256 - 64; idx = idx < 0 ? 0 : (idx > 256 ? 256 : idx); ((float*)lds)[i] = p.rel_bias[l * 8 * 257 + hh_ * 257 + idx] * 1.4426950408889634f; }
            __syncthreads();
            REPS(8) for (int it = bx; it < 32; it += G) attn_item<true>(p, l, it, lds);
            { const int vb = (G & 7) == 0 ? (bx & 7) * (G >> 3) + (bx >> 3) : bx;
              REPS(9) for (int it = vb; it < 512; it += G) attn_prompt_item(p, l, it, lds); }
            hgrn_passA_phase(p, l, lds);
        }
        SEAM(base + 1);
        if (IN(base + 2)) { const Params p = load_params(); hgrn_scan(p, l); }
        SEAM(base + 2);
        if (IN(base + 3)) REPS(4) { const Params p = load_params(); hgrn_passC_phase(p, l); }
        SEAM(base + 3);
        if (IN(base + 4)) {
            const Params p = load_params(); unsigned char* ws = p.ws;
            __syncthreads();
            pg8::Gemm g{(const bf16_t*)(ws + WS_OB), (const bf16_t*)(ws + WS_WOUT) + (size_t)l * DM * DM, T_ALL, DM, DM, DM};
            pg8::StaticOrder S; S.init(T_ALL, DM, lgrid(), lbid());
            EpiRes<0> E{l, 0};
            pg8::gemm_phase<EpiRes<0>, pg8::StaticOrder, false>((PG8_LAS unsigned char*)lds, g, S, E, nullptr);
        }
        SEAM(base + 4);
        if (IN(base + 5)) REPS(6) {
            const Params p = load_params(); unsigned char* ws = p.ws;
            pg8::Gemm g{(const bf16_t*)(ws + WS_XB), (const bf16_t*)(ws + WS_WUP) + (size_t)l * DFF * DM, T_ALL, DFF, DM, DM};
            pg8::StaticOrder S; S.init(T_ALL, DFF, lgrid(), lbid());
            EpiUp E{l};
            pg8::gemm_phase<EpiUp, pg8::StaticOrder, false>((PG8_LAS unsigned char*)lds, g, S, E, nullptr);
        }
        SEAM(base + 5);
        if (IN(base + 6)) {
            const Params p = load_params(); unsigned char* ws = p.ws;
            {
                pg8::Gemm g{(const bf16_t*)(ws + WS_U), (const bf16_t*)(ws + WS_WDN) + (size_t)l * DM * DFF, T_P, DM, DFF, DFF};
                pg8::StaticOrder S; S.init(T_P, DM, lgrid(), lbid());
                EpiRes<1> E{l, 0};
                    pg8::gemm_phase<EpiRes<1>, pg8::StaticOrder, false>((PG8_LAS unsigned char*)lds, g, S, E, nullptr);
            }
            {
                pg8::Gemm g{(const bf16_t*)(ws + WS_U), (const bf16_t*)(ws + WS_WDN) + (size_t)l * DM * DFF, T_ALL, DM, DFF / 4, DFF};
                SplitOrder S; S.c = lbid();
                EpiSplit E{l};
                pg8::gemm_phase<EpiSplit, SplitOrder, false>((PG8_LAS unsigned char*)lds, g, S, E, nullptr);
            }
        }
        SEAM(base + 6);
    }
#ifdef XSYNC
    for (int i_ = 0; i_ < XSYNC; ++i_) { ++nsync; my_grid_sync((unsigned*)(load_params().ws + WS_BAR), nsync * (unsigned)gridDim.x); }
#endif
    if (IN(15)) { const Params p = load_params(); final_norm(p); }
#undef IN
#undef SEAM
}

extern "C" void kernel_launch(void* const* d_in, const int* in_sizes, int n_in, void* d_out, int out_size, void* d_ws, size_t ws_size, hipStream_t stream) {
    static int grid = 0;
    if (grid == 0) {
        if (n_in != 16 || ws_size < WS_END) { fprintf(stderr, "kernel_launch: need 16 inputs and >= %zu bytes of workspace; got %d, %zu\n", (size_t)WS_END, n_in, ws_size); grid = -1; return; }
        int dev = 0, cus = 0, per_cu = 0;
        (void)hipGetDevice(&dev); (void)hipDeviceGetAttribute(&cus, hipDeviceAttributeMultiprocessorCount, dev);
        if (hipFuncSetAttribute((const void*)hymba_fwd, hipFuncAttributeMaxDynamicSharedMemorySize, LDS_BYTES) != hipSuccess) { fprintf(stderr, "kernel_launch: hipFuncSetAttribute failed\n"); grid = -1; return; }
        if (hipOccupancyMaxActiveBlocksPerMultiprocessor(&per_cu, (const void*)hymba_fwd, 512, LDS_BYTES) != hipSuccess || per_cu < 1) { fprintf(stderr, "kernel_launch: occupancy query says %d\n", per_cu); per_cu = 1; }
        (void)hipGetLastError();
        grid = cus;
    }
    if (grid < 0) return;
    Params p{};
    const float** pp = (const float**)&p;
    for (int i = 0; i < 16; ++i) pp[i] = (const float*)d_in[i];
    p.out = (float*)d_out; p.ws = (unsigned char*)d_ws;
#if MK_ONE_LAUNCH
    (void)hipMemsetAsync((unsigned char*)d_ws + WS_BAR, 0, 16384, stream);
    p.ph_lo = 0; p.ph_hi = 16;
    void* args[] = {&p};
    hipError_t e = hipLaunchCooperativeKernel((const void*)hymba_fwd, dim3(grid), dim3(512), args, LDS_BYTES, stream);
    if (e != hipSuccess) fprintf(stderr, "cooperative launch failed: %s (grid %d)\n", hipGetErrorString(e), grid);
#else
    for (int ph = 0; ph < 16; ++ph) { p.ph_lo = ph; p.ph_hi = ph + 1; hipLaunchKernelGGL(hymba_fwd, dim3(grid), dim3(512), LDS_BYTES, stream, p); }
#endif
}
```

```cpp
#include <hip/hip_runtime.h>
#include <hip/hip_cooperative_groups.h>
#include <cstdio>
namespace cg = cooperative_groups;
namespace pg8 {
#define PG8_LAS __attribute__((address_space(3)))
typedef unsigned short bf16_t;
typedef short bf16x8 __attribute__((ext_vector_type(8)));
typedef float f32x4 __attribute__((ext_vector_type(4)));
typedef unsigned u32x4 __attribute__((ext_vector_type(4)));
constexpr int BM = 256, BK = 64, HALF = 128, HTB = HALF * BK * 2  , STAGE_BYTES = 8 * HTB, NXCD = 8, WGM = 8;

__host__ __device__ __forceinline__ int lds_byte(int r, int c) { const int st = (r >> 4) * 2 + (c >> 5), rr = r & 15, cc = c & 31, ob = rr * 64 + cc * 2; return st * 1024 + (ob ^ (((ob >> 9) & 1) << 5)); }
__host__ __device__ __forceinline__ void stage_rc(int b, int& R, int& C) { const int st = b / 1024, sb = b % 1024, swz = sb ^ (((sb >> 9) & 1) << 5); R = (st >> 1) * 16 + swz / 64; C = (st & 1) * 32 + (swz % 64) / 2; }
__host__ __device__ __forceinline__ int perm32(int rho) { const int n = rho >> 4, i = rho & 15; return 8 * (i >> 2) + 4 * n + (i & 3); }

struct Unit { int pm, pn, k0; };
struct Gemm { const bf16_t* A; const bf16_t* Bt; int M, N, K, ld; };

struct StaticOrder {
    int nM, nN, nwg, G, c;
    __host__ __device__ void init(int M, int N, int G_, int c_) { nM = M / BM; nN = N / BM; nwg = nM * nN; G = G_; c = c_; }
    __host__ __device__ bool next(int i, Unit& u) const {
        const long L = (long)i * G + c; if (L >= nwg) return false;
        int wgid = (int)L; { const int q = nwg / NXCD, r = nwg % NXCD, xcd = wgid % NXCD, off = wgid / NXCD; wgid = (xcd < r ? xcd * (q + 1) : r * (q + 1) + (xcd - r) * q) + off; }
        const int nig = WGM * nN, gid = wgid / nig, fm = gid * WGM, gsz = (nM - fm) < WGM ? (nM - fm) : WGM;
        u.pm = fm + ((wgid % nig) % gsz); u.pn = (wgid % nig) / gsz; u.k0 = 0; return true;
    }
    __device__ __forceinline__ void a_ready(const Unit&) const {}
    __device__ __forceinline__ void done(const Unit&) const {}
};
__device__ __forceinline__ unsigned cvt_pk_bf16(float lo, float hi) { unsigned r; asm volatile("v_cvt_pk_bf16_f32 %0, %1, %2" : "=v"(r) : "v"(lo), "v"(hi)); return r; }

template <class Epi, class Sched, bool STAMP = false>
__device__ __forceinline__ void gemm_phase(PG8_LAS unsigned char* lds, const Gemm g, const Sched& S, const Epi& E, unsigned long long* stamps) {
    int tid_l = threadIdx.x; asm volatile("" : "+v"(tid_l)); const int tid = tid_l, wid = __builtin_amdgcn_readfirstlane(tid >> 6), lane = tid & 63, wr = wid >> 2, wc = wid & 3, fr = lane & 15, fq = lane >> 4;
    const int K = g.K, nt = K / BK, LD = g.ld;
    int ts_lo = 0, ts_hi = 0, nts = 0; const unsigned long long rt_entry = STAMP ? (unsigned long long)wall_clock64() : 0ull;
#define PG8_STAMP() do { if (STAMP && wid == 0 && nts < 64) { const unsigned long long _c = (unsigned long long)clock64(); \
        ts_lo = (lane == nts) ? (int)(unsigned)_c : ts_lo; ts_hi = (lane == nts) ? (int)(unsigned)(_c >> 32) : ts_hi; ++nts; } } while (0)
    PG8_STAMP();
    unsigned voffA[2], voffB[2];
#pragma unroll
    for (int i = 0; i < 2; ++i) { int R, C; stage_rc(tid * 16 + i * 8192, R, C); const int Rb = Epi::PERM ? ((R & ~31) + perm32(R & 31)) : R;
        voffA[i] = (unsigned)(R * LD + C) * 2u; voffB[i] = (unsigned)(Rb * LD + C) * 2u; }
    const size_t kstep = (size_t)(BK * 2);
    const size_t hstep = (size_t)HALF * LD * 2;
    const size_t tstep = 2 * hstep;
    const unsigned ldsw = (unsigned)wid * 1024u;
    const int aoff = lds_byte(wr * 64 + fr, fq * 8), boff = lds_byte(wc * 32 + fr, fq * 8);
#define PG8_SA(b, h) (((b) * 2 + (h)) * HTB)
#define PG8_SB(b, h) ((4 + (b) * 2 + (h)) * HTB)
#define PG8_STAGE(bufoff, gbase, voff) do { _Pragma("unroll") for (int _i = 0; _i < 2; ++_i) \
        __builtin_amdgcn_global_load_lds((const unsigned*)((const char*)(gbase) + (voff)[_i]), (PG8_LAS unsigned*)(lds + (bufoff) + ldsw + _i * 8192), 16, 0, 0); } while (0)
#define PG8_LDA(dst, b, h) do { _Pragma("unroll") for (int m = 0; m < 4; ++m) _Pragma("unroll") for (int k = 0; k < 2; ++k) dst[m][k] = *(const PG8_LAS bf16x8*)(lds + PG8_SA(b, h) + aoff + m * 2048 + k * 1024); } while (0)
#define PG8_LDB(dst, b, h) do { _Pragma("unroll") for (int n = 0; n < 2; ++n) _Pragma("unroll") for (int k = 0; k < 2; ++k) dst[n][k] = *(const PG8_LAS bf16x8*)(lds + PG8_SB(b, h) + boff + n * 2048 + k * 1024); } while (0)
#define PG8_MMA(ai, bj, At, Bt) do { __builtin_amdgcn_s_setprio(1); _Pragma("unroll") for (int m = 0; m < 4; ++m) _Pragma("unroll") for (int n = 0; n < 2; ++n) _Pragma("unroll") for (int k = 0; k < 2; ++k) \
        acc[ai][bj][m][n] = __builtin_amdgcn_mfma_f32_16x16x32_bf16(Bt[n][k], At[m][k], acc[ai][bj][m][n], 0, 0, 0); __builtin_amdgcn_s_setprio(0); } while (0)
#define PG8_WAIT_V(n) asm volatile("s_waitcnt vmcnt(" #n ")" ::: "memory")
#define PG8_WAIT_L(n) asm volatile("s_waitcnt lgkmcnt(" #n ")" ::: "memory")
#define PG8_BAR __builtin_amdgcn_s_barrier()
#define PG8_SCHED __builtin_amdgcn_sched_barrier(0)
    Unit cur, nxt; int ui = 0;
    if (!S.next(0, cur)) return;
    f32x4 acc[2][2][4][2];
#pragma unroll
    for (int a = 0; a < 2; ++a)
#pragma unroll
        for (int b = 0; b < 2; ++b)
#pragma unroll
            for (int m = 0; m < 4; ++m)
#pragma unroll
                for (int n = 0; n < 2; ++n) acc[a][b][m][n] = (f32x4){0.f, 0.f, 0.f, 0.f};
    bf16x8 At[4][2], B0[2][2], B1[2][2];
    const char* cA = (const char*)g.A + (size_t)cur.pm * tstep + (size_t)cur.k0 * 2; const char* cB = (const char*)g.Bt + (size_t)cur.pn * tstep + (size_t)cur.k0 * 2;
    S.a_ready(cur);
    PG8_STAGE(PG8_SB(0, 0), cB, voffB); PG8_STAGE(PG8_SA(0, 0), cA, voffA); PG8_STAGE(PG8_SB(0, 1), cB + hstep, voffB); PG8_STAGE(PG8_SA(0, 1), cA + hstep, voffA);
    if (wr == 1) PG8_BAR;
    PG8_WAIT_V(4); PG8_BAR;
    PG8_STAGE(PG8_SB(1, 0), cB + kstep, voffB); PG8_STAGE(PG8_SA(1, 0), cA + kstep, voffA); PG8_STAGE(PG8_SB(1, 1), cB + hstep + kstep, voffB);
    PG8_WAIT_V(6); PG8_BAR;
    PG8_STAMP();
    for (;;) {
        const bool has_next = S.next(ui + 1, nxt);
        const char* nA = has_next ? (const char*)g.A + (size_t)nxt.pm * tstep + (size_t)nxt.k0 * 2 : cA; const char* nB = has_next ? (const char*)g.Bt + (size_t)nxt.pn * tstep + (size_t)nxt.k0 * 2 : cB;
        for (int t = 0; t < nt; t += 2) {
            const bool last = (t == nt - 2);
            const char* a1 = cA + (size_t)(t + 1) * kstep;
            const char* a2 = last ? nA : cA + (size_t)(t + 2) * kstep; const char* b2 = last ? nB : cB + (size_t)(t + 2) * kstep;
            const char* a3 = a2 + kstep; const char* b3 = b2 + kstep;
            if (last && has_next) S.a_ready(nxt);
            PG8_LDB(B0, 0, 0); PG8_SCHED; PG8_LDA(At, 0, 0); PG8_STAGE(PG8_SA(1, 1), a1 + hstep, voffA);
            PG8_WAIT_L(8); PG8_BAR; PG8_WAIT_L(0); PG8_MMA(0, 0, At, B0); PG8_BAR; PG8_SCHED;
            PG8_LDB(B1, 0, 1); PG8_STAGE(PG8_SB(0, 0), b2, voffB);
            PG8_BAR; PG8_WAIT_L(0); PG8_MMA(0, 1, At, B1); PG8_BAR;
            PG8_LDA(At, 0, 1); PG8_STAGE(PG8_SA(0, 0), a2, voffA);
            PG8_BAR; PG8_WAIT_L(0); PG8_MMA(1, 0, At, B0); PG8_BAR; PG8_SCHED;
            PG8_STAGE(PG8_SB(0, 1), b2 + hstep, voffB);
            PG8_WAIT_V(6); PG8_BAR; PG8_MMA(1, 1, At, B1); PG8_BAR;
            PG8_LDB(B0, 1, 0); PG8_SCHED; PG8_LDA(At, 1, 0); PG8_STAGE(PG8_SA(0, 1), a2 + hstep, voffA);
            PG8_WAIT_L(8); PG8_BAR; PG8_WAIT_L(0); PG8_MMA(0, 0, At, B0); PG8_BAR; PG8_SCHED;
            PG8_LDB(B1, 1, 1); PG8_STAGE(PG8_SB(1, 0), b3, voffB);
            PG8_BAR; PG8_WAIT_L(0); PG8_MMA(0, 1, At, B1); PG8_BAR;
            PG8_LDA(At, 1, 1); PG8_STAGE(PG8_SA(1, 0), a3, voffA);
            PG8_BAR; PG8_WAIT_L(0); PG8_MMA(1, 0, At, B0); PG8_BAR; PG8_SCHED;
            PG8_STAGE(PG8_SB(1, 1), b3 + hstep, voffB);
            PG8_WAIT_V(6); PG8_BAR; PG8_MMA(1, 1, At, B1); PG8_BAR;
        }
        PG8_STAMP();
        if constexpr (!Epi::AFTER_DRAIN) { E(acc, cur, wr, wc, fr, fq); S.done(cur); }
        PG8_STAMP();
        if (!has_next) break;
#pragma unroll
        for (int a = 0; a < 2; ++a)
#pragma unroll
            for (int b = 0; b < 2; ++b)
#pragma unroll
                for (int m = 0; m < 4; ++m)
#pragma unroll
                    for (int n = 0; n < 2; ++n) acc[a][b][m][n] = (f32x4){0.f, 0.f, 0.f, 0.f};
        cur = nxt; cA = nA; cB = nB; ++ui;
    }
    PG8_WAIT_V(0);
    if (wr == 0) PG8_BAR;
    PG8_BAR;
    if constexpr (Epi::AFTER_DRAIN) { E.fused(acc, cur, wr, wc, fr, fq, lds, wid, lane); S.done(cur); }
    PG8_STAMP();
    if (STAMP && wid == 0) { stamps[lane] = lane < nts ? (((unsigned long long)(unsigned)ts_hi << 32) | (unsigned)ts_lo) : 0ull;
        if (lane == 62) stamps[62] = rt_entry; if (lane == 63) stamps[63] = (unsigned long long)wall_clock64(); }
#undef PG8_STAMP
#undef PG8_SA
#undef PG8_SB
#undef PG8_STAGE
#undef PG8_LDA
#undef PG8_LDB
#undef PG8_MMA
#undef PG8_WAIT_V
#undef PG8_WAIT_L
#undef PG8_BAR
#undef PG8_SCHED
}
}

using pg8::bf16_t; using pg8::bf16x8; using pg8::f32x4; using pg8::Unit;
typedef float f32x16 __attribute__((ext_vector_type(16)));
typedef unsigned u32x2 __attribute__((ext_vector_type(2)));
typedef unsigned u32x4v __attribute__((ext_vector_type(4)));

#ifndef MK_ONE_LAUNCH
#define MK_ONE_LAUNCH 1
#endif

constexpr int T_P = 32768, T_S = 512, T_ALL = 33280, DM = 1024, NIN = 3584, DFF = 4096, TPAD = 33344;
constexpr float EPSF = 1e-6f;
constexpr size_t O_Y = 0, O_SP = 34078720, O_KP = 34603008, O_VP = 36700160, O_SS = 38797312, O_KS = 42991616, O_VS = 43515904;
constexpr size_t WS_WIN = 0, WS_WOUT = WS_WIN + 2ull * NIN * DM * 2, WS_WUP = WS_WOUT + 2ull * DM * DM * 2, WS_WDN = WS_WUP + 2ull * DFF * DM * 2,
                 WS_XB = WS_WDN + 2ull * DFF * DM * 2, WS_OB = WS_XB + (size_t)T_ALL * DM * 2, WS_U = WS_OB + (size_t)T_ALL * DM * 2,
                 SZ_P = (size_t)T_ALL * 512 * 2, WS_QH = WS_U, WS_GH = WS_U + SZ_P, WS_QA = WS_U + 2 * SZ_P, WS_KA = WS_U + 3 * SZ_P, WS_LF = WS_U + 4 * SZ_P,
                 WS_VT = WS_LF + (size_t)T_ALL * 512 * 4, WS_ST = WS_VT + (size_t)1024 * TPAD * 2, N_ITEMS = 2176, WS_D = WS_ST + N_ITEMS * 32768ull,
                 WS_SS = WS_D + N_ITEMS * 512ull, WS_BAR = WS_SS + 5ull * T_ALL * 4, WS_LB = WS_BAR + 16384, WS_END = WS_LB + 4096;
static_assert(WS_VT + (size_t)1024 * TPAD * 2 >= WS_U + (size_t)T_ALL * DFF * 2, "U region");
constexpr int LDS_BYTES = pg8::STAGE_BYTES + 8 * 2560 + 16;

struct Params {
    const float *x_prompt, *x_sample, *state_hgrn, *cache_k, *cache_v, *lb_param, *norm1_g, *w_in, *hg_norm_g, *rel_bias, *att_norm_g, *w_out, *norm2_g, *w_up, *w_down, *final_g;
    float* out; unsigned char* ws; int ph_lo, ph_hi;
};

__device__ __forceinline__ float bf2f(bf16_t b) { return __uint_as_float(((unsigned)b) << 16); }
__device__ __forceinline__ bf16_t f2bf(float f) { unsigned u = __float_as_uint(f); u += 0x7fffu + ((u >> 16) & 1u); return (bf16_t)(u >> 16); }
typedef __bf16 bf16v2_t __attribute__((ext_vector_type(2)));
__device__ __forceinline__ unsigned pk2(float lo, float hi) { bf16v2_t v; v[0] = (__bf16)lo; v[1] = (__bf16)hi; return __builtin_bit_cast(unsigned, v); }
__device__ __forceinline__ bf16x8 pack8(const float* v) {
    u32x4v r; r[0] = pk2(v[0], v[1]); r[1] = pk2(v[2], v[3]); r[2] = pk2(v[4], v[5]); r[3] = pk2(v[6], v[7]);
    return __builtin_bit_cast(bf16x8, r);
}
__device__ __forceinline__ float xor32(float v) { return __shfl_xor(v, 32, 64); }

typedef const Params __attribute__((address_space(4)))* KP;
__device__ __forceinline__ KP kparams() { unsigned long long a = (unsigned long long)__builtin_amdgcn_kernarg_segment_ptr(); asm volatile("" : "+s"(a)); return (KP)a; }
__device__ __forceinline__ Params load_params() { KP kp = kparams(); Params p; p.x_prompt = kp->x_prompt; p.x_sample = kp->x_sample; p.state_hgrn = kp->state_hgrn; p.cache_k = kp->cache_k; p.cache_v = kp->cache_v; p.lb_param = kp->lb_param; p.norm1_g = kp->norm1_g; p.w_in = kp->w_in; p.hg_norm_g = kp->hg_norm_g; p.rel_bias = kp->rel_bias; p.att_norm_g = kp->att_norm_g; p.w_out = kp->w_out; p.norm2_g = kp->norm2_g; p.w_up = kp->w_up; p.w_down = kp->w_down; p.final_g = kp->final_g; p.out = kp->out; p.ws = kp->ws; p.ph_lo = kp->ph_lo; p.ph_hi = kp->ph_hi; return p; }
#ifndef NOTYPE
#define NOTYPE -1
#endif
struct EpiIn {
    static constexpr bool PERM = true, AFTER_DRAIN = false;
    int l; PG8_LAS unsigned char* xt; int skip;
    template <int TYPE> __device__ __forceinline__ void run(const f32x4 (&acc)[2][2][4][2], const Unit& u, int wr, int wc, int fr, int fq) const {
        const Params P = load_params(); unsigned char* ws = P.ws; const float* ss = (const float*)(ws + WS_SS) + 2 * l * T_ALL; const float* lbp = P.lb_param; float* out = P.out;
        bf16_t* QH = (bf16_t*)(ws + WS_QH); bf16_t* GH = (bf16_t*)(ws + WS_GH); bf16_t* QA = (bf16_t*)(ws + WS_QA); bf16_t* KA = (bf16_t*)(ws + WS_KA); bf16_t* VT = (bf16_t*)(ws + WS_VT); float* LF = (float*)(ws + WS_LF);
        (void)lbp; (void)out; (void)QH; (void)GH; (void)QA; (void)KA; (void)VT; (void)LF;
        const int cbase = (u.pn & 1) * 256 + wc * 32 + 8 * fq;
        f32x4 lbv[2][2];
        if constexpr (TYPE == 1) { const float* LB = (const float*)(ws + WS_LB) + l * 512 + cbase;
#pragma unroll
            for (int bj = 0; bj < 2; ++bj) { lbv[bj][0] = *(const f32x4*)(LB + bj * 128); lbv[bj][1] = *(const f32x4*)(LB + bj * 128 + 4); } }
        float rs8[2][4];
#pragma unroll
        for (int ai = 0; ai < 2; ++ai)
#pragma unroll
            for (int m = 0; m < 4; ++m) rs8[ai][m] = ss[u.pm * 256 + ai * 128 + wr * 64 + m * 16 + fr];
#pragma unroll
        for (int ai = 0; ai < 2; ++ai) {
            float rs4[4];
#pragma unroll
            for (int m = 0; m < 4; ++m) rs4[m] = rsqrtf(rs8[ai][m] * (1.0f / 1024.0f) + EPSF);
#pragma unroll
            for (int bj = 0; bj < 2; ++bj)
#pragma unroll
                for (int m = 0; m < 4; ++m) {
                    const int row = u.pm * 256 + ai * 128 + wr * 64 + m * 16 + fr;
                    const float rstd = rs4[m];
                    const int cb = cbase + bj * 128;
                    float v[8];
#pragma unroll
                    for (int j = 0; j < 4; ++j) { v[j] = acc[ai][bj][m][0][j] * rstd; v[4 + j] = acc[ai][bj][m][1][j] * rstd; }
                    if constexpr (TYPE == 0) { *(bf16x8*)(QH + (size_t)row * 512 + cb) = pack8(v); }
                    else if constexpr (TYPE == 1) {
                        float o[8];
#pragma unroll
                        for (int j = 0; j < 8; ++j) {
                            const float lb = j < 4 ? lbv[bj][0][j & 3] : lbv[bj][1][j & 3];
                            const float sg = __builtin_amdgcn_rcpf(1.0f + __expf(-v[j]));
                            o[j] = __builtin_amdgcn_logf(lb + (1.0f - lb) * sg) * 0.6931471805599453f;
                        }
                        float* d = LF + (size_t)row * 512 + cb;
                        *(f32x4*)d = (f32x4){o[0], o[1], o[2], o[3]}; *(f32x4*)(d + 4) = (f32x4){o[4], o[5], o[6], o[7]};
                    }
                    else if constexpr (TYPE == 2 || TYPE == 6) {
                        PG8_LAS bf16_t* T = (PG8_LAS bf16_t*)(xt + (wr * 4 + wc) * 2560);
#pragma unroll
                        for (int j = 0; j < 8; ++j) T[(8 * fq + j) * 36 + 16 * (m & 1) + fr] = f2bf(v[j]);
                        if (m & 1) {
                            asm volatile("s_waitcnt lgkmcnt(0)" ::: "memory");
                            const int lane = fq * 16 + fr, col = lane >> 1, half = lane & 1;
                            const PG8_LAS u32x2* src = (const PG8_LAS u32x2*)(T + col * 36 + 16 * half);
                            const u32x2 a0 = src[0], a1 = src[1], a2 = src[2], a3 = src[3];
                            bf16_t* d = VT + (size_t)((TYPE == 6 ? 512 : 0) + (u.pn & 1) * 256 + wc * 32 + bj * 128 + col) * TPAD + (u.pm * 256 + ai * 128 + wr * 64 + (m - 1) * 16 + 16 * half);
                            u32x4v w0, w1; w0[0] = a0[0]; w0[1] = a0[1]; w0[2] = a1[0]; w0[3] = a1[1]; w1[0] = a2[0]; w1[1] = a2[1]; w1[2] = a3[0]; w1[3] = a3[1];
                            *(u32x4v*)d = w0; *(u32x4v*)(d + 8) = w1;
                            asm volatile("s_waitcnt lgkmcnt(0)" ::: "memory");
                        }
                    }
                    else if constexpr (TYPE == 3) {
                        float o[8];
#pragma unroll
                        for (int j = 0; j < 8; ++j) o[j] = v[j] * __builtin_amdgcn_rcpf(1.0f + __expf(-v[j]));
                        *(bf16x8*)(GH + (size_t)row * 512 + cb) = pack8(o);
                    }
                    else if constexpr (TYPE == 4) {
                        float o[8];
#pragma unroll
                        for (int j = 0; j < 8; ++j) o[j] = v[j] * (0.125f * 1.4426950408889634f);
                        *(bf16x8*)(QA + (size_t)row * 512 + cb) = pack8(o);
                    }
                    if constexpr (TYPE == 5) { *(bf16x8*)(KA + (size_t)row * 512 + cb) = pack8(v); }
                    if constexpr (TYPE == 5 || TYPE == 6) {
                        float* d = nullptr;
                        if (row >= T_P) d = out + (TYPE == 5 ? O_KS : O_VS) + ((size_t)l * 512 + (row - T_P)) * 512 + cb;
                        else { const int t = row & 8191, b = row >> 13; if (t >= 7680) d = out + (TYPE == 5 ? O_KP : O_VP) + (((size_t)l * 4 + b) * 512 + (t - 7680)) * 512 + cb; }
                        if (d) { *(f32x4*)d = (f32x4){v[0], v[1], v[2], v[3]}; *(f32x4*)(d + 4) = (f32x4){v[4], v[5], v[6], v[7]}; }
                    }
                }
        }
    }
    __device__ __forceinline__ void operator()(const f32x4 (&acc)[2][2][4][2], const Unit& u, int wr, int wc, int fr, int fq) const {
#ifndef PMASK
#define PMASK 0
#endif
        if (skip && !((PMASK >> (u.pn >> 1)) & 1)) return;
        switch (u.pn >> 1) {
            case 0: if (NOTYPE != 0) run<0>(acc, u, wr, wc, fr, fq); break;
            case 1: if (NOTYPE != 1) run<1>(acc, u, wr, wc, fr, fq); break;
            case 2: if (NOTYPE != 2) run<2>(acc, u, wr, wc, fr, fq); break;
            case 3: if (NOTYPE != 3) run<3>(acc, u, wr, wc, fr, fq); break;
            case 4: if (NOTYPE != 4) run<4>(acc, u, wr, wc, fr, fq); break;
            case 5: if (NOTYPE != 5) run<5>(acc, u, wr, wc, fr, fq); break;
            default: if (NOTYPE != 6) run<6>(acc, u, wr, wc, fr, fq); break;
        }
    }
};

template <int MODE> struct EpiRes {
    static constexpr bool PERM = true, AFTER_DRAIN = false;
    int l, noatom;
    __device__ __forceinline__ void operator()(const f32x4 (&acc)[2][2][4][2], const Unit& u, int wr, int wc, int fr, int fq) const {
        const Params P = load_params(); unsigned char* ws = P.ws; bf16_t* XB = (bf16_t*)(ws + WS_XB);
        float* ssn = (float*)(ws + WS_SS) + (2 * l + 1 + MODE) * T_ALL;
        const int cbase = u.pn * 256 + wc * 32 + 8 * fq;
        bf16_t* xp = XB + (size_t)(u.pm * 256 + wr * 64 + fr) * DM + cbase;
        u32x4v rb[2][4][2];
#pragma unroll
        for (int ai = 0; ai < 2; ++ai)
#pragma unroll
            for (int m = 0; m < 4; ++m)
#pragma unroll
                for (int bj = 0; bj < 2; ++bj) rb[ai][m][bj] = *(const u32x4v*)(xp + (size_t)(ai * 128 + m * 16) * DM + bj * 128);
#pragma unroll
        for (int ai = 0; ai < 2; ++ai)
#pragma unroll
            for (int m = 0; m < 4; ++m) {
                const int row = u.pm * 256 + ai * 128 + wr * 64 + m * 16 + fr;
                float s = 0.f;
#pragma unroll
                for (int bj = 0; bj < 2; ++bj) {
                    float x[8];
                    const u32x4v r4 = rb[ai][m][bj];
#pragma unroll
                    for (int j = 0; j < 4; ++j) {
                        x[2 * j] = __uint_as_float(r4[j] << 16) + (j < 2 ? acc[ai][bj][m][0][2 * j] : acc[ai][bj][m][1][2 * j - 4]);
                        x[2 * j + 1] = __uint_as_float(r4[j] & 0xffff0000u) + (j < 2 ? acc[ai][bj][m][0][2 * j + 1] : acc[ai][bj][m][1][2 * j - 3]);
                    }
#pragma unroll
                    for (int j = 0; j < 8; ++j) s += x[j] * x[j];
                    *(bf16x8*)(xp + (size_t)(ai * 128 + m * 16) * DM + bj * 128) = pack8(x);
                }
                s += __shfl_xor(s, 16, 64); s += __shfl_xor(s, 32, 64);
                if (fq == 0 && !noatom) atomicAdd(ssn + row, s);
            }
    }
};

struct SplitOrder {
    int c;
    __device__ __forceinline__ bool next(int i, Unit& u) const { if (i != 0 || c >= 32) return false; u.pm = 128 + (c >> 4); u.pn = (c >> 2) & 3; u.k0 = (c & 3) * (DFF / 4); return true; }
    __device__ __forceinline__ void a_ready(const Unit&) const {}
    __device__ __forceinline__ void done(const Unit&) const {}
};
struct EpiSplit {
    static constexpr bool PERM = true, AFTER_DRAIN = true;
    int l;
    __device__ __forceinline__ void operator()(const f32x4 (&acc)[2][2][4][2], const Unit& u, int wr, int wc, int fr, int fq) const {}
    __device__ __forceinline__ void fused(const f32x4 (&acc)[2][2][4][2], const Unit& u, int wr, int wc, int fr, int fq, PG8_LAS unsigned char* lds, int wid, int lane) const {
        const Params P = load_params(); unsigned char* ws = P.ws; bf16_t* XB = (bf16_t*)(ws + WS_XB);
        float* PART = (float*)(ws + WS_OB);
        float* ssn = (float*)(ws + WS_SS) + (2 * l + 2) * T_ALL;
        unsigned* cnt = (unsigned*)(ws + WS_BAR) + 3584 + l * 8 + (u.pm - 128) * 4 + u.pn;
        const int ks = u.k0 / (DFF / 4);
        const int cbase = u.pn * 256 + wc * 32 + 8 * fq;
#pragma unroll
        for (int ai = 0; ai < 2; ++ai)
#pragma unroll
            for (int m = 0; m < 4; ++m) {
                const int rs = (u.pm - 128) * 256 + ai * 128 + wr * 64 + m * 16 + fr;
#pragma unroll
                for (int bj = 0; bj < 2; ++bj) {
                    float* d = PART + ((size_t)ks * 512 + rs) * DM + cbase + bj * 128;
                    *(f32x4*)d = acc[ai][bj][m][0]; *(f32x4*)(d + 4) = acc[ai][bj][m][1];
                }
            }
        __builtin_amdgcn_fence(__ATOMIC_RELEASE, "agent");
        asm volatile("s_waitcnt vmcnt(0)" ::: "memory");
        __syncthreads();
        PG8_LAS unsigned* flag = (PG8_LAS unsigned*)lds;
        if (wid == 0 && lane == 0) *flag = __hip_atomic_fetch_add(cnt, 1u, __ATOMIC_RELAXED, __HIP_MEMORY_SCOPE_AGENT);
        __syncthreads();
        const unsigned old = *flag;
        if (old != 3u) return;
        __builtin_amdgcn_fence(__ATOMIC_ACQUIRE, "agent");
#pragma unroll
        for (int ai = 0; ai < 2; ++ai)
#pragma unroll
            for (int m = 0; m < 4; ++m) {
                const int rs = (u.pm - 128) * 256 + ai * 128 + wr * 64 + m * 16 + fr, row = T_P + rs;
                float s = 0.f;
                f32x4 pt[2][4][2]; u32x4v rbv[2];
#pragma unroll
                for (int bj = 0; bj < 2; ++bj) {
                    const int c = cbase + bj * 128;
                    rbv[bj] = *(const u32x4v*)(XB + (size_t)row * DM + c);
#pragma unroll
                    for (int q = 0; q < 4; ++q) { const float* sp = PART + ((size_t)q * 512 + rs) * DM + c; pt[bj][q][0] = *(const f32x4*)sp; pt[bj][q][1] = *(const f32x4*)(sp + 4); }
                }
#pragma unroll
                for (int bj = 0; bj < 2; ++bj) {
                    const int c = cbase + bj * 128;
                    const u32x4v rb = rbv[bj];
                    f32x4 t0 = (f32x4){0.f, 0.f, 0.f, 0.f}, t1 = t0;
#pragma unroll
                    for (int q = 0; q < 4; ++q) {
                        if (q == ks) { t0 += acc[ai][bj][m][0]; t1 += acc[ai][bj][m][1]; }
                        else { t0 += pt[bj][q][0]; t1 += pt[bj][q][1]; }
                    }
                    float x[8];
#pragma unroll
                    for (int j = 0; j < 4; ++j) {
                        x[2 * j] = __uint_as_float(rb[j] << 16) + (j < 2 ? t0[2 * j] : t1[2 * j - 4]);
                        x[2 * j + 1] = __uint_as_float(rb[j] & 0xffff0000u) + (j < 2 ? t0[2 * j + 1] : t1[2 * j - 3]);
                    }
#pragma unroll
                    for (int j = 0; j < 8; ++j) s += x[j] * x[j];
                    *(bf16x8*)(XB + (size_t)row * DM + c) = pack8(x);
                }
                s += __shfl_xor(s, 16, 64); s += __shfl_xor(s, 32, 64);
                if (fq == 0) atomicAdd(ssn + row, s);
            }
    }
};

struct EpiUp {
    static constexpr bool PERM = true, AFTER_DRAIN = false;
    int l;
    __device__ __forceinline__ void operator()(const f32x4 (&acc)[2][2][4][2], const Unit& u, int wr, int wc, int fr, int fq) const {
        const Params P = load_params(); unsigned char* ws = P.ws; const float* ss = (const float*)(ws + WS_SS) + (2 * l + 1) * T_ALL; bf16_t* U = (bf16_t*)(ws + WS_U);
        const int cbase = u.pn * 256 + wc * 32 + 8 * fq;
        float rs8[2][4];
#pragma unroll
        for (int ai = 0; ai < 2; ++ai)
#pragma unroll
            for (int m = 0; m < 4; ++m) rs8[ai][m] = ss[u.pm * 256 + ai * 128 + wr * 64 + m * 16 + fr];
#pragma unroll
        for (int ai = 0; ai < 2; ++ai)
#pragma unroll
            for (int m = 0; m < 4; ++m) {
                const int row = u.pm * 256 + ai * 128 + wr * 64 + m * 16 + fr;
                const float rstd = rsqrtf(rs8[ai][m] * (1.0f / 1024.0f) + EPSF);
#pragma unroll
                for (int bj = 0; bj < 2; ++bj) {
                    float v[8];
#pragma unroll
                    for (int j = 0; j < 4; ++j) {
                        float a = fmaxf(acc[ai][bj][m][0][j] * rstd, 0.f), b = fmaxf(acc[ai][bj][m][1][j] * rstd, 0.f);
                        v[j] = a * a; v[4 + j] = b * b;
                    }
                    *(bf16x8*)(U + (size_t)row * DFF + cbase + bj * 128) = pack8(v);
                }
            }
    }
};

struct WtItem { const float* W; const float* g; bf16_t* WT; int K, N, k0, n0; };
__device__ __forceinline__ WtItem wt_item(const Params& p, int it) {
    WtItem x; const int l = it / 3200; int r = it % 3200;
    if (r < 896) { x.W = p.w_in + (size_t)l * DM * NIN; x.g = p.norm1_g + l * DM; x.WT = (bf16_t*)(p.ws + WS_WIN) + (size_t)l * NIN * DM; x.K = DM; x.N = NIN; x.k0 = (r / 56) * 64; x.n0 = (r % 56) * 64; }
    else if (r < 1152) { r -= 896; x.W = p.w_out + (size_t)l * DM * DM; x.g = nullptr; x.WT = (bf16_t*)(p.ws + WS_WOUT) + (size_t)l * DM * DM; x.K = DM; x.N = DM; x.k0 = (r / 16) * 64; x.n0 = (r % 16) * 64; }
    else if (r < 2176) { r -= 1152; x.W = p.w_up + (size_t)l * DM * DFF; x.g = p.norm2_g + l * DM; x.WT = (bf16_t*)(p.ws + WS_WUP) + (size_t)l * DFF * DM; x.K = DM; x.N = DFF; x.k0 = (r / 64) * 64; x.n0 = (r % 64) * 64; }
    else { r -= 2176; x.W = p.w_down + (size_t)l * DFF * DM; x.g = nullptr; x.WT = (bf16_t*)(p.ws + WS_WDN) + (size_t)l * DM * DFF; x.K = DFF; x.N = DM; x.k0 = (r / 16) * 64; x.n0 = (r % 16) * 64; }
    return x;
}
__device__ __forceinline__ void prologue(const Params& p, unsigned char* lds) {
    int tid_l = threadIdx.x; asm volatile("" : "+v"(tid_l)); const int tid = tid_l, wid = tid >> 6, lane = tid & 63;
    float* SS = (float*)(p.ws + WS_SS);
    for (size_t i = (size_t)blockIdx.x * 512 + tid; i < 4ull * T_ALL; i += (size_t)gridDim.x * 512) SS[T_ALL + i] = 0.f;
    if (blockIdx.x == 0) { float* LB = (float*)(p.ws + WS_LB); LB[tid] = 0.f; LB[512 + tid] = 1.0f / (1.0f + __expf(p.lb_param[tid] - p.lb_param[512 + tid])); }
    const int G = gridDim.x;
    {
        float* tile = (float*)lds;
        const int kA = tid >> 4, n4 = (tid & 15) * 4;
        const int nB = tid >> 3, k8 = (tid & 7) * 8;
        int it = blockIdx.x;
        f32x4 v0, v1; float s0 = 1.f, s1 = 1.f;
        if (it < 6400) { const WtItem x = wt_item(p, it); v0 = *(const f32x4*)(x.W + (size_t)(x.k0 + kA) * x.N + x.n0 + n4); v1 = *(const f32x4*)(x.W + (size_t)(x.k0 + kA + 32) * x.N + x.n0 + n4);
            if (x.g) { s0 = x.g[x.k0 + kA]; s1 = x.g[x.k0 + kA + 32]; } }
        for (; it < 6400; it += G) {
            const WtItem x = wt_item(p, it);
#pragma unroll
            for (int j = 0; j < 4; ++j) { tile[kA * 65 + n4 + j] = v0[j] * s0; tile[(kA + 32) * 65 + n4 + j] = v1[j] * s1; }
            __syncthreads();
            if (it + G < 6400) { const WtItem y = wt_item(p, it + G); v0 = *(const f32x4*)(y.W + (size_t)(y.k0 + kA) * y.N + y.n0 + n4); v1 = *(const f32x4*)(y.W + (size_t)(y.k0 + kA + 32) * y.N + y.n0 + n4);
                s0 = 1.f; s1 = 1.f; if (y.g) { s0 = y.g[y.k0 + kA]; s1 = y.g[y.k0 + kA + 32]; } }
            float v[8];
#pragma unroll
            for (int j = 0; j < 8; ++j) v[j] = tile[(k8 + j) * 65 + nB];
            *(bf16x8*)(x.WT + (size_t)(x.n0 + nB) * x.K + x.k0 + k8) = pack8(v);
            __syncthreads();
        }
    }
    for (int it = blockIdx.x; it < T_ALL / 16; it += G) {
        const int row0 = it * 16 + wid * 2;
        f32x4 v[2][4];
#pragma unroll
        for (int rr = 0; rr < 2; ++rr) { const int row = row0 + rr; const float* xr = row >= T_P ? p.x_sample + (size_t)(row - T_P) * DM : p.x_prompt + (size_t)row * DM;
#pragma unroll
            for (int i = 0; i < 4; ++i) v[rr][i] = *(const f32x4*)(xr + lane * 4 + 256 * i); }
#pragma unroll
        for (int rr = 0; rr < 2; ++rr) { const int row = row0 + rr; bf16_t* xb = (bf16_t*)(p.ws + WS_XB) + (size_t)row * DM; float s = 0.f;
#pragma unroll
            for (int i = 0; i < 4; ++i) { const f32x4 w = v[rr][i]; s += w[0] * w[0] + w[1] * w[1] + w[2] * w[2] + w[3] * w[3]; u32x2 o; o[0] = pk2(w[0], w[1]); o[1] = pk2(w[2], w[3]); *(u32x2*)(xb + lane * 4 + 256 * i) = o; }
#pragma unroll
            for (int o = 32; o > 0; o >>= 1) s += __shfl_xor(s, o, 64);
            if (lane == 0) SS[row] = s; }
    }
}

__device__ __forceinline__ void final_norm(const Params& p) {
    int tid_l = threadIdx.x; asm volatile("" : "+v"(tid_l)); const int tid = tid_l, wid = tid >> 6, lane = tid & 63;
    const float* SS4 = (const float*)(p.ws + WS_SS) + 4 * T_ALL;
    const bf16_t* XB = (const bf16_t*)(p.ws + WS_XB);
    f32x4 g[2][2];
#pragma unroll
    for (int i = 0; i < 2; ++i) { g[i][0] = *(const f32x4*)(p.final_g + lane * 8 + 512 * i); g[i][1] = *(const f32x4*)(p.final_g + lane * 8 + 512 * i + 4); }
    for (int it = blockIdx.x; it < T_ALL / 32; it += gridDim.x) {
        const int row0 = it * 32 + wid * 4;
        u32x4v rb[4][2]; float ssv[4];
#pragma unroll
        for (int rr = 0; rr < 4; ++rr) { ssv[rr] = SS4[row0 + rr];
#pragma unroll
            for (int i = 0; i < 2; ++i) rb[rr][i] = *(const u32x4v*)(XB + (size_t)(row0 + rr) * DM + lane * 8 + 512 * i); }
#pragma unroll
        for (int rr = 0; rr < 4; ++rr) {
            float* yr = p.out + (size_t)(row0 + rr) * DM;
            const float rstd = rsqrtf(ssv[rr] * (1.0f / 1024.0f) + EPSF);
#pragma unroll
            for (int i = 0; i < 2; ++i) {
                const u32x4v w = rb[rr][i]; const f32x4 g0 = g[i][0], g1 = g[i][1];
                f32x4 y0, y1;
                y0[0] = __uint_as_float(w[0] << 16) * rstd * g0[0]; y0[1] = __uint_as_float(w[0] & 0xffff0000u) * rstd * g0[1];
                y0[2] = __uint_as_float(w[1] << 16) * rstd * g0[2]; y0[3] = __uint_as_float(w[1] & 0xffff0000u) * rstd * g0[3];
                y1[0] = __uint_as_float(w[2] << 16) * rstd * g1[0]; y1[1] = __uint_as_float(w[2] & 0xffff0000u) * rstd * g1[1];
                y1[2] = __uint_as_float(w[3] << 16) * rstd * g1[2]; y1[3] = __uint_as_float(w[3] & 0xffff0000u) * rstd * g1[3];
                *(f32x4*)(yr + lane * 8 + 512 * i) = y0; *(f32x4*)(yr + lane * 8 + 512 * i + 4) = y1;
            }
        }
    }
}

template <bool SAMPLE>
__device__ __forceinline__ void attn_item(const Params& p, int l, int item, unsigned char* lds) {
    int tid_l = threadIdx.x; asm volatile("" : "+v"(tid_l)); const int tid = tid_l, h = tid >> 6, lane = tid & 63, r = lane & 31, hh = lane >> 5;
    const float* tab = (const float*)lds + h * 256;
    float* ssq = (float*)(lds + 8448);
    constexpr int NQT = SAMPLE ? 1 : 2;
    const bf16_t* QA = (const bf16_t*)(p.ws + WS_QA); const bf16_t* KA = (const bf16_t*)(p.ws + WS_KA); const bf16_t* VT = (const bf16_t*)(p.ws + WS_VT);
    bf16_t* OB = (bf16_t*)(p.ws + WS_OB);
    int tq, b = 0, c = 0, jstart = 0, ntiles;
    if (SAMPLE) { tq = T_P + item * 16; ntiles = 17; }
    else { b = item >> 7; c = item & 127; tq = b * 8192 + c * 64; jstart = c * 64 - 512; if (jstart < 0) jstart = 0; ntiles = (c * 64 + 64 - jstart) >> 5; }
    bf16x8 qf[NQT][4];
#pragma unroll
    for (int qt = 0; qt < NQT; ++qt)
#pragma unroll
        for (int ks = 0; ks < 4; ++ks) {
            const int qrow = SAMPLE ? (r < 15 ? r : 15) : 32 * qt + r;
            qf[qt][ks] = *(const bf16x8*)(QA + (size_t)(tq + qrow) * 512 + h * 64 + 16 * ks + 8 * hh);
        }
    f32x16 o[2][NQT];
    float mrun[NQT], lsum[NQT];
#pragma unroll
    for (int qt = 0; qt < NQT; ++qt) { mrun[qt] = -1e30f; lsum[qt] = 0.f;
#pragma unroll
        for (int dt = 0; dt < 2; ++dt)
#pragma unroll
            for (int i = 0; i < 16; ++i) o[dt][qt][i] = 0.f; }
    bf16x8 kf[4], vf[2][2];
    auto load_bf = [&](int kt, bf16x8 (&kfd)[4], bf16x8 (&vfd)[2][2]) {
        const size_t krow = SAMPLE ? (size_t)(tq + (r < 15 ? r : 15)) : (size_t)(b * 8192 + jstart + kt * 32 + r);
#pragma unroll
        for (int ks = 0; ks < 4; ++ks) kfd[ks] = *(const bf16x8*)(KA + krow * 512 + h * 64 + 16 * ks + 8 * hh);
        const size_t vcol = SAMPLE ? (size_t)tq : (size_t)(b * 8192 + jstart + kt * 32);
#pragma unroll
        for (int dt = 0; dt < 2; ++dt)
#pragma unroll
            for (int ks2 = 0; ks2 < 2; ++ks2) {
                const bf16_t* vp = VT + (size_t)(512 + h * 64 + 32 * dt + r) * TPAD + vcol + 16 * ks2 + 4 * hh;
                const u32x2 lo = *(const u32x2*)vp, hi = *(const u32x2*)(vp + 8);
                u32x4v w; w[0] = lo[0]; w[1] = lo[1]; w[2] = hi[0]; w[3] = hi[1];
                vfd[dt][ks2] = __builtin_bit_cast(bf16x8, w);
            }
    };
    f32x4 kraw[8]; float vraw[32];
    auto load_cache = [&](int kt) {
        const float* kp = p.cache_k + ((size_t)(l * 32 + item) * 512 + kt * 32 + r) * 512 + h * 64 + 8 * hh;
#pragma unroll
        for (int ks = 0; ks < 4; ++ks) { kraw[2 * ks] = *(const f32x4*)(kp + 16 * ks); kraw[2 * ks + 1] = *(const f32x4*)(kp + 16 * ks + 4); }
        const float* vp = p.cache_v + ((size_t)(l * 32 + item) * 512 + kt * 32) * 512 + h * 64;
#pragma unroll
        for (int dt = 0; dt < 2; ++dt)
#pragma unroll
            for (int ks2 = 0; ks2 < 2; ++ks2)
#pragma unroll
                for (int j = 0; j < 8; ++j) { const int key = 16 * ks2 + 8 * (j >> 2) + 4 * hh + (j & 3); vraw[(dt * 2 + ks2) * 8 + j] = vp[(size_t)key * 512 + 32 * dt + r]; }
    };
    if (!SAMPLE) load_bf(0, kf, vf); else load_cache(0);
    for (int kt = 0; kt < ntiles; ++kt) {
        bf16x8 kfn[4], vfn[2][2];
        int relbase;
        const bool cache_tile = SAMPLE && kt < 16;
        if (SAMPLE) {
            if (cache_tile) {
#pragma unroll
                for (int ks = 0; ks < 4; ++ks) { const f32x4 a0 = kraw[2 * ks], a1 = kraw[2 * ks + 1]; float t8[8] = {a0[0], a0[1], a0[2], a0[3], a1[0], a1[1], a1[2], a1[3]}; kf[ks] = pack8(t8); }
#pragma unroll
                for (int dt = 0; dt < 2; ++dt)
#pragma unroll
                    for (int ks2 = 0; ks2 < 2; ++ks2) vf[dt][ks2] = pack8(vraw + (dt * 2 + ks2) * 8);
                if (kt + 1 < 16) load_cache(kt + 1);
                relbase = kt * 32 - 512;
            } else if (false) {
                const float* kp = p.cache_k + ((size_t)(l * 32 + item) * 512 + kt * 32 + r) * 512 + h * 64 + 8 * hh;
#pragma unroll
                for (int ks = 0; ks < 4; ++ks) {
                    const f32x4 a0 = *(const f32x4*)(kp + 16 * ks), a1 = *(const f32x4*)(kp + 16 * ks + 4);
                    float t8[8] = {a0[0], a0[1], a0[2], a0[3], a1[0], a1[1], a1[2], a1[3]};
                    kf[ks] = pack8(t8);
                }
                const float* vp = p.cache_v + ((size_t)(l * 32 + item) * 512 + kt * 32) * 512 + h * 64;
#pragma unroll
                for (int dt = 0; dt < 2; ++dt)
#pragma unroll
                    for (int ks2 = 0; ks2 < 2; ++ks2) {
                        float t8[8];
#pragma unroll
                        for (int j = 0; j < 8; ++j) { const int key = 16 * ks2 + 8 * (j >> 2) + 4 * hh + (j & 3); t8[j] = vp[(size_t)key * 512 + 32 * dt + r]; }
                        vf[dt][ks2] = pack8(t8);
                    }
                relbase = kt * 32 - 512;
            } else { load_bf(kt, kf, vf); relbase = 0; }
        } else {
            if (kt + 1 < ntiles) load_bf(kt + 1, kfn, vfn);
            relbase = jstart + kt * 32 - c * 64;
        }
        bf16x8 pf[NQT][2];
        const bool uni = (relbase + 31 <= -128);
        const float bias0 = tab[0];
#pragma unroll
        for (int qt = 0; qt < NQT; ++qt) {
            f32x16 st;
#pragma unroll
            for (int i = 0; i < 16; ++i) st[i] = 0.f;
#pragma unroll
            for (int ks = 0; ks < 4; ++ks) st = __builtin_amdgcn_mfma_f32_32x32x16_bf16(kf[ks], qf[qt][ks], st, 0, 0, 0);
            const int q = SAMPLE ? r : 32 * qt + r;
            float sv[16];
            if (uni) {
#pragma unroll
                for (int i = 0; i < 16; ++i) sv[i] = st[i] + bias0;
            } else {
                const float* tb = tab + (relbase - q + 192 + 4 * hh);
#pragma unroll
                for (int i = 0; i < 16; ++i) {
                    sv[i] = st[i] + tb[(i & 3) + 8 * (i >> 2)];
                    if (SAMPLE && !cache_tile && (i & 3) + 8 * (i >> 2) + 4 * hh >= 16) sv[i] = -1e30f;
                }
            }
            float mx = sv[0];
#pragma unroll
            for (int i = 1; i < 16; ++i) mx = fmaxf(mx, sv[i]);
            mx = fmaxf(mx, xor32(mx));
            if (__builtin_amdgcn_ballot_w64(mx > mrun[qt] + 8.0f) != 0ull) {
                const float mnew = fmaxf(mrun[qt], mx), alpha = __builtin_amdgcn_exp2f(mrun[qt] - mnew);
                mrun[qt] = mnew; lsum[qt] *= alpha;
#pragma unroll
                for (int dt = 0; dt < 2; ++dt)
#pragma unroll
                    for (int i = 0; i < 16; ++i) o[dt][qt][i] *= alpha;
            }
            float ps = 0.f;
#pragma unroll
            for (int i = 0; i < 16; ++i) { sv[i] = __builtin_amdgcn_exp2f(sv[i] - mrun[qt]); ps += sv[i]; }
            lsum[qt] += ps;
            pf[qt][0] = pack8(sv); pf[qt][1] = pack8(sv + 8);
        }
#pragma unroll
        for (int qt = 0; qt < NQT; ++qt)
#pragma unroll
            for (int dt = 0; dt < 2; ++dt)
#pragma unroll
                for (int ks2 = 0; ks2 < 2; ++ks2) o[dt][qt] = __builtin_amdgcn_mfma_f32_32x32x16_bf16(vf[dt][ks2], pf[qt][ks2], o[dt][qt], 0, 0, 0);
        if (!SAMPLE) {
#pragma unroll
            for (int ks = 0; ks < 4; ++ks) kf[ks] = kfn[ks];
#pragma unroll
            for (int dt = 0; dt < 2; ++dt)
#pragma unroll
                for (int ks2 = 0; ks2 < 2; ++ks2) vf[dt][ks2] = vfn[dt][ks2];
        }
    }
#pragma unroll
    for (int qt = 0; qt < NQT; ++qt) {
        const float lt = lsum[qt] + xor32(lsum[qt]), inv = 1.0f / lt;
        float sq = 0.f;
#pragma unroll
        for (int dt = 0; dt < 2; ++dt)
#pragma unroll
            for (int i = 0; i < 16; ++i) { const float v = o[dt][qt][i] * inv; o[dt][qt][i] = v; sq += v * v; }
        sq += xor32(sq);
        if (hh == 0) ssq[h * 64 + 32 * qt + r] = sq;
    }
    __syncthreads();
    const float* ga = p.att_norm_g + l * 512 + h * 64;
    f32x4 gav[2][4];
#pragma unroll
    for (int dt = 0; dt < 2; ++dt)
#pragma unroll
        for (int ig = 0; ig < 4; ++ig) gav[dt][ig] = *(const f32x4*)(ga + 32 * dt + 8 * ig + 4 * hh);
#pragma unroll
    for (int qt = 0; qt < NQT; ++qt) {
        const int q = 32 * qt + r;
        float tot = 0.f;
#pragma unroll
        for (int h2 = 0; h2 < 8; ++h2) tot += ssq[h2 * 64 + q];
        const float rstd = rsqrtf(tot * (1.0f / 512.0f) + EPSF);
        if (!SAMPLE || r < 16) {
#pragma unroll
            for (int dt = 0; dt < 2; ++dt)
#pragma unroll
                for (int ig = 0; ig < 4; ++ig) {
                    const int d0 = 32 * dt + 8 * ig + 4 * hh;
                    const f32x4 g = gav[dt][ig];
                    u32x2 w; w[0] = pk2(o[dt][qt][4 * ig] * rstd * g[0], o[dt][qt][4 * ig + 1] * rstd * g[1]); w[1] = pk2(o[dt][qt][4 * ig + 2] * rstd * g[2], o[dt][qt][4 * ig + 3] * rstd * g[3]);
                    *(u32x2*)(OB + (size_t)(tq + q) * DM + 512 + h * 64 + d0) = w;
                }
        }
    }
    __syncthreads();
}

__device__ __forceinline__ void attn_prompt_item(const Params& p, int l, int item, unsigned char* lds) {
    int tid_l = threadIdx.x; asm volatile("" : "+v"(tid_l)); const int tid = tid_l, h = tid >> 6, lane = tid & 63, r = lane & 31, hh = lane >> 5;
    const float* tab = (const float*)lds + h * 256;
    float* ssq = (float*)(lds + 8448);
    unsigned char* KT = lds + 16384 + h * 16384; unsigned char* VTl = KT + 4096; unsigned char* QT = KT + 8192;
    const bf16_t* QA = (const bf16_t*)(p.ws + WS_QA); const bf16_t* KA = (const bf16_t*)(p.ws + WS_KA); const bf16_t* VT = (const bf16_t*)(p.ws + WS_VT);
    bf16_t* OB = (bf16_t*)(p.ws + WS_OB);
    const int b = item >> 7, c = item & 127, tq = b * 8192 + c * 64;
    int jstart = c * 64 - 512; if (jstart < 0) jstart = 0;
    const int ntiles = (c * 64 + 64 - jstart) >> 5;
    {
#pragma unroll
        for (int j = 0; j < 8; ++j) {
            const int q = 8 * j + (lane >> 3), ch = lane & 7;
            *(u32x4v*)(QT + q * 128 + ((ch ^ ((q >> 1) & 7)) * 16)) = *(const u32x4v*)(QA + (size_t)(tq + q) * 512 + h * 64 + ch * 8);
        }
    }
    f32x16 o[2][2];
    float mrun[2], lsum[2];
#pragma unroll
    for (int qt = 0; qt < 2; ++qt) { mrun[qt] = -1e30f; lsum[qt] = 0.f;
#pragma unroll
        for (int dt = 0; dt < 2; ++dt)
#pragma unroll
            for (int i = 0; i < 16; ++i) o[dt][qt][i] = 0.f; }
    const int kkey = lane >> 3, kch = lane & 7;
    const int vd = lane >> 2, vc = lane & 3;
    const bf16_t* kg = KA + (size_t)(b * 8192 + jstart + kkey) * 512 + h * 64 + kch * 8;
    const bf16_t* vg = VT + (size_t)(512 + h * 64 + vd) * TPAD + (size_t)(b * 8192 + jstart) + vc * 8;
    u32x4v kraw[4], vraw[4];
#pragma unroll
    for (int j = 0; j < 4; ++j) { kraw[j] = *(const u32x4v*)(kg + (size_t)(8 * j) * 512); vraw[j] = *(const u32x4v*)(vg + (size_t)(16 * j) * TPAD); }
    const float bias0 = tab[0];
    for (int kt = 0; kt < ntiles; ++kt) {
#pragma unroll
        for (int j = 0; j < 4; ++j) {
            const int key = 8 * j + kkey;
            *(u32x4v*)(KT + key * 128 + ((kch ^ ((key >> 1) & 7)) * 16)) = kraw[j];
            const int d = 16 * j + vd, g = (d >> 2) & 7;
            u32x2 lo, hi; lo[0] = vraw[j][0]; lo[1] = vraw[j][1]; hi[0] = vraw[j][2]; hi[1] = vraw[j][3];
            *(u32x2*)(VTl + d * 64 + (((2 * vc) ^ g) * 8)) = lo;
            *(u32x2*)(VTl + d * 64 + (((2 * vc + 1) ^ g) * 8)) = hi;
        }
        if (kt + 1 < ntiles) {
#pragma unroll
            for (int j = 0; j < 4; ++j) { kraw[j] = *(const u32x4v*)(kg + (size_t)((kt + 1) * 32 + 8 * j) * 512); vraw[j] = *(const u32x4v*)(vg + (size_t)(16 * j) * TPAD + (kt + 1) * 32); }
        }
        const int relbase = jstart + kt * 32 - c * 64;
        const bool uni = (relbase + 31 <= -128);
#pragma unroll
        for (int qt = 0; qt < 2; ++qt) {
            asm volatile("" ::: "memory");
            f32x16 st;
#pragma unroll
            for (int i = 0; i < 16; ++i) st[i] = 0.f;
#pragma unroll
            for (int ks = 0; ks < 4; ++ks) st = __builtin_amdgcn_mfma_f32_32x32x16_bf16(*(const bf16x8*)(KT + r * 128 + (((2 * ks + hh) ^ ((r >> 1) & 7)) * 16)), *(const bf16x8*)(QT + (32 * qt + r) * 128 + (((2 * ks + hh) ^ (((32 * qt + r) >> 1) & 7)) * 16)), st, 0, 0, 0);
            const int q = 32 * qt + r;
            float sv[16];
            if (uni) {
#pragma unroll
                for (int i = 0; i < 16; ++i) sv[i] = st[i] + bias0;
            } else {
                const float* tb = tab + (relbase - q + 192 + 4 * hh);
#pragma unroll
                for (int i = 0; i < 16; ++i) sv[i] = st[i] + tb[(i & 3) + 8 * (i >> 2)];
            }
            float mx = sv[0];
#pragma unroll
            for (int i = 1; i < 16; ++i) mx = fmaxf(mx, sv[i]);
            mx = fmaxf(mx, xor32(mx));
            if (__builtin_amdgcn_ballot_w64(mx > mrun[qt] + 8.0f) != 0ull) {
                const float mnew = fmaxf(mrun[qt], mx), alpha = __builtin_amdgcn_exp2f(mrun[qt] - mnew);
                mrun[qt] = mnew; lsum[qt] *= alpha;
#pragma unroll
                for (int dt = 0; dt < 2; ++dt)
#pragma unroll
                    for (int i = 0; i < 16; ++i) o[dt][qt][i] *= alpha;
            }
            float ps = 0.f;
#pragma unroll
            for (int i = 0; i < 16; ++i) { sv[i] = __builtin_amdgcn_exp2f(sv[i] - mrun[qt]); ps += sv[i]; }
            lsum[qt] += ps;
            bf16x8 pf[2];
            pf[0] = pack8(sv); pf[1] = pack8(sv + 8);
#pragma unroll
            for (int dt = 0; dt < 2; ++dt)
#pragma unroll
                for (int ks2 = 0; ks2 < 2; ++ks2) {
                    const int d = 32 * dt + r, g = (d >> 2) & 7, u = 4 * ks2 + hh;
                    const u32x2 lo = *(const u32x2*)(VTl + d * 64 + ((u ^ g) * 8)), hi = *(const u32x2*)(VTl + d * 64 + (((u + 2) ^ g) * 8));
                    u32x4v w; w[0] = lo[0]; w[1] = lo[1]; w[2] = hi[0]; w[3] = hi[1];
                    o[dt][qt] = __builtin_amdgcn_mfma_f32_32x32x16_bf16(__builtin_bit_cast(bf16x8, w), pf[ks2], o[dt][qt], 0, 0, 0);
                }
        }
    }
#pragma unroll
    for (int qt = 0; qt < 2; ++qt) {
        const float lt = lsum[qt] + xor32(lsum[qt]), inv = 1.0f / lt;
        float sq = 0.f;
#pragma unroll
        for (int dt = 0; dt < 2; ++dt)
#pragma unroll
            for (int i = 0; i < 16; ++i) { const float v = o[dt][qt][i] * inv; o[dt][qt][i] = v; sq += v * v; }
        sq += xor32(sq);
        if (hh == 0) ssq[h * 64 + 32 * qt + r] = sq;
    }
    __syncthreads();
    const float* ga = p.att_norm_g + l * 512 + h * 64;
    f32x4 gav[2][4];
#pragma unroll
    for (int dt = 0; dt < 2; ++dt)
#pragma unroll
        for (int ig = 0; ig < 4; ++ig) gav[dt][ig] = *(const f32x4*)(ga + 32 * dt + 8 * ig + 4 * hh);
#pragma unroll
    for (int qt = 0; qt < 2; ++qt) {
        const int q = 32 * qt + r;
        float tot = 0.f;
#pragma unroll
        for (int h2 = 0; h2 < 8; ++h2) tot += ssq[h2 * 64 + q];
        const float rstd = rsqrtf(tot * (1.0f / 512.0f) + EPSF);
#pragma unroll
        for (int dt = 0; dt < 2; ++dt)
#pragma unroll
            for (int ig = 0; ig < 4; ++ig) {
                const int d0 = 32 * dt + 8 * ig + 4 * hh;
                const f32x4 g = gav[dt][ig];
                u32x2 w; w[0] = pk2(o[dt][qt][4 * ig] * rstd * g[0], o[dt][qt][4 * ig + 1] * rstd * g[1]); w[1] = pk2(o[dt][qt][4 * ig + 2] * rstd * g[2], o[dt][qt][4 * ig + 3] * rstd * g[3]);
                *(u32x2*)(OB + (size_t)(tq + q) * DM + 512 + h * 64 + d0) = w;
            }
    }
    __syncthreads();
}

struct HItem { int tb, nt, h; };
__device__ __forceinline__ HItem hitem(int it) {
    HItem x;
    if (it < 2048) { const int b = it >> 9, c = it & 127; x.h = (it >> 7) & 3; x.tb = b * 8192 + c * 64; x.nt = 64; }
    else { const int j = it - 2048; x.h = j & 3; x.tb = T_P + (j >> 2) * 16; x.nt = 16; }
    return x;
}
__device__ __forceinline__ int passA_index(int bx, int G, int j) {
    if (G != 256) { const int it = bx + G * j; return it < 2176 ? it : -1; }
    const int nA = bx >= 32 ? 8 : 0;
    if (j < nA) return (bx - 32) + 224 * j;
    if (j == nA) return 1792 + bx;
    if (j == nA + 1 && bx < 128) return 2048 + bx;
    return -1;
}
__device__ __forceinline__ void hgrn_passA_phase(const Params& p, int l, unsigned char* lds) {
    int tid_l = threadIdx.x; asm volatile("" : "+v"(tid_l)); const int tid = tid_l, wid = tid >> 6, lane = tid & 63, r = lane & 31, hh = lane >> 5, k = tid & 127, seg = tid >> 7;
    const int bx = blockIdx.x, G = gridDim.x;
    float* tot = (float*)(lds + 16384); bf16_t* khT = (bf16_t*)(lds + 16384 + 2048); float* dl = (float*)(lds + 16384 + 2048 + 18432);
    float* LF = (float*)(p.ws + WS_LF); bf16_t* LFb = (bf16_t*)(p.ws + WS_LF); const bf16_t* VT = (const bf16_t*)(p.ws + WS_VT); bf16_t* QH = (bf16_t*)(p.ws + WS_QH);
    float lf[16]; bf16_t qr[16];
    unsigned* qctr = (unsigned*)(p.ws + WS_BAR) + 3700 + l;
    volatile PG8_LAS int* qw = (volatile PG8_LAS int*)((PG8_LAS unsigned char*)lds + 16384 + 2048 + 18432 + 512);
    bf16_t* Q1s = (bf16_t*)(lds + 40960); bf16_t* Q2s = (bf16_t*)(lds + 57344); bf16_t* K2s = (bf16_t*)(lds + 73728);
    (void)bx; (void)G;
    if (tid == 0) { const unsigned q0 = __hip_atomic_fetch_add(qctr, 1u, __ATOMIC_RELAXED, __HIP_MEMORY_SCOPE_AGENT), q1 = __hip_atomic_fetch_add(qctr, 1u, __ATOMIC_RELAXED, __HIP_MEMORY_SCOPE_AGENT); qw[0] = (int)q0; qw[1] = (int)q1; }
    __syncthreads();
    auto qmap = [](int q) { return q >= 2176 ? -1 : (q < 128 ? 2048 + q : q - 128); };
    int it = qmap(qw[0]), itn = qmap(qw[1]);
    if (it >= 0) { const HItem X = hitem(it);
#pragma unroll
        for (int j = 0; j < 16; ++j) { const int t = seg * 16 + j; const bool ok = t < X.nt; lf[j] = ok ? LF[(size_t)(X.tb + t) * 512 + X.h * 128 + k] : 0.f; qr[j] = ok ? QH[(size_t)(X.tb + t) * 512 + X.h * 128 + k] : (bf16_t)0; } }
    while (it >= 0) {
        const HItem X = hitem(it);
        unsigned qnn = 0u; if (tid == 0) qnn = __hip_atomic_fetch_add(qctr, 1u, __ATOMIC_RELAXED, __HIP_MEMORY_SCOPE_AGENT);
        bf16_t* ST = (bf16_t*)(p.ws + WS_ST) + (size_t)it * 16384; float* D = (float*)(p.ws + WS_D) + (size_t)it * 128;
        const int kt = wid & 3, vt0 = 2 * (wid >> 2);
        bf16x8 vfr[4][2];
#pragma unroll
        for (int ks = 0; ks < 4; ++ks)
#pragma unroll
            for (int e = 0; e < 2; ++e) vfr[ks][e] = *(const bf16x8*)(VT + (size_t)(X.h * 128 + (vt0 + e) * 32 + r) * TPAD + X.tb + 16 * ks + 8 * hh);
        float bb[16];
        { float run = 0.f;
#pragma unroll
          for (int j = 0; j < 16; ++j) { run += lf[j]; bb[j] = run; }
          tot[seg * 128 + k] = run; }
        __syncthreads();
        const float t0 = tot[k], t1 = tot[128 + k], t2 = tot[256 + k], t3 = tot[384 + k];
        const float off = (seg > 0 ? t0 : 0.f) + (seg > 1 ? t1 : 0.f) + (seg > 2 ? t2 : 0.f), blast = t0 + t1 + t2 + t3, bmid = t0 + t1;
        {
            float kh[16];
#pragma unroll
            for (int j = 0; j < 16; ++j) {
                const int t = seg * 16 + j;
                const float bj = bb[j] + off, kk = 1.0f - __expf(lf[j]), q = bf2f(qr[j]);
                kh[j] = kk * __expf(blast - bj);
                Q1s[t * 128 + k] = f2bf(q * __expf(bj));
                Q2s[t * 128 + k] = f2bf(q * __expf(bj - bmid));
                K2s[t * 128 + k] = f2bf(kk * __expf(bmid - bj));
            }
            bf16_t* d = khT + k * 72 + seg * 16;
            *(bf16x8*)d = pack8(kh); *(bf16x8*)(d + 8) = pack8(kh + 8);
            if (seg == 0) { const float dk = __expf(blast); D[k] = dk; dl[k] = dk; }
        }
        if (itn >= 0) { const HItem Y = hitem(itn);
#pragma unroll
            for (int j = 0; j < 16; ++j) { const int t = seg * 16 + j; const bool ok = t < Y.nt; lf[j] = ok ? LF[(size_t)(Y.tb + t) * 512 + Y.h * 128 + k] : 0.f; qr[j] = ok ? QH[(size_t)(Y.tb + t) * 512 + Y.h * 128 + k] : (bf16_t)0; } }
        __syncthreads();
#pragma unroll
        for (int i = 0; i < 2; ++i) {
            const int c = tid + 512 * i, t = c >> 4, kc = (c & 15) * 8;
            if (t < X.nt) {
                const size_t row = (size_t)(X.tb + t);
                *(u32x4v*)(QH + row * 512 + X.h * 128 + kc) = *(const u32x4v*)(Q1s + t * 128 + kc);
                *(u32x4v*)(LFb + row * 1024 + X.h * 256 + kc) = *(const u32x4v*)(Q2s + t * 128 + kc);
                *(u32x4v*)(LFb + row * 1024 + X.h * 256 + 128 + kc) = *(const u32x4v*)(K2s + t * 128 + kc);
            }
        }
        {
            f32x16 acc[2];
#pragma unroll
            for (int e = 0; e < 2; ++e)
#pragma unroll
                for (int i = 0; i < 16; ++i) acc[e][i] = 0.f;
#pragma unroll
            for (int ks = 0; ks < 4; ++ks) {
                const bf16x8 a = *(const bf16x8*)(khT + (kt * 32 + r) * 72 + 16 * ks + 8 * hh);
#pragma unroll
                for (int e = 0; e < 2; ++e) {
                    acc[e] = __builtin_amdgcn_mfma_f32_32x32x16_bf16(a, vfr[ks][e], acc[e], 0, 0, 0);
                }
            }
            if (it >= 2048) {
                const int sj = it - 2048;
                const float* s0p = p.state_hgrn + ((size_t)l * 128 + sj) * 16384; float* fin = p.out + O_SS + ((size_t)l * 128 + sj) * 16384;
#pragma unroll
                for (int e = 0; e < 2; ++e) {
                    const int v = (vt0 + e) * 32 + r;
                    float s0v[16];
#pragma unroll
                    for (int i = 0; i < 16; ++i) s0v[i] = s0p[(size_t)(kt * 32 + (i & 3) + 8 * (i >> 2) + 4 * hh) * 128 + v];
#pragma unroll
                    for (int i = 0; i < 16; ++i) { const int kk = kt * 32 + (i & 3) + 8 * (i >> 2) + 4 * hh; fin[(size_t)kk * 128 + v] = dl[kk] * s0v[i] + acc[e][i]; }
#pragma unroll
                    for (int ig = 0; ig < 4; ++ig) {
                        u32x2 w; w[0] = pk2(s0v[4 * ig], s0v[4 * ig + 1]); w[1] = pk2(s0v[4 * ig + 2], s0v[4 * ig + 3]);
                        *(u32x2*)(ST + (size_t)v * 128 + kt * 32 + 8 * ig + 4 * hh) = w;
                    }
                }
            } else {
#pragma unroll
            for (int e = 0; e < 2; ++e)
#pragma unroll
                for (int ig = 0; ig < 4; ++ig) {
                    u32x2 w; w[0] = pk2(acc[e][4 * ig], acc[e][4 * ig + 1]); w[1] = pk2(acc[e][4 * ig + 2], acc[e][4 * ig + 3]);
                    *(u32x2*)(ST + (size_t)((vt0 + e) * 32 + r) * 128 + kt * 32 + 8 * ig + 4 * hh) = w;
                }
            }
        }
        if (tid == 0) qw[0] = (int)qnn;
        __syncthreads();
        it = itn; itn = qmap(qw[0]);
    }
}

__device__ __forceinline__ void hgrn_scan(const Params& p, int l) {
    int tid_l = threadIdx.x; asm volatile("" : "+v"(tid_l)); const int tid = tid_l;
    typedef float f32x2v __attribute__((ext_vector_type(2)));
    for (int u = blockIdx.x; u < 256; u += gridDim.x) {
        const int seq = u >> 4, sub = u & 15, item0 = seq * 128;
        float* fin = p.out + O_SP + ((size_t)l * 16 + seq) * 16384;
        const int e = sub * 1024 + tid * 2, v = e >> 7, k = e & 127;
        float S0 = 0.f, S1 = 0.f;
        unsigned* stp = (unsigned*)((bf16_t*)(p.ws + WS_ST) + (size_t)item0 * 16384 + e);
        const float* dp = (const float*)(p.ws + WS_D) + (size_t)item0 * 128 + k;
        for (int c0 = 0; c0 < 128; c0 += 16) {
            unsigned Lr[16]; f32x2v dd[16];
#pragma unroll
            for (int j = 0; j < 16; ++j) { Lr[j] = stp[(size_t)(c0 + j) * 8192]; dd[j] = *(const f32x2v*)(dp + (size_t)(c0 + j) * 128); }
#pragma unroll
            for (int j = 0; j < 16; ++j) {
                stp[(size_t)(c0 + j) * 8192] = pk2(S0, S1);
                S0 = dd[j][0] * S0 + __uint_as_float(Lr[j] << 16); S1 = dd[j][1] * S1 + __uint_as_float(Lr[j] & 0xffff0000u);
            }
        }
        fin[k * 128 + v] = S0; fin[(k + 1) * 128 + v] = S1;
    }
}

__device__ __forceinline__ void hgrn_passC_phase(const Params& p, int l) {
    int tid_l = threadIdx.x; asm volatile("" : "+v"(tid_l)); const int tid = tid_l, wid = tid >> 6, lane = tid & 63, r = lane & 31, hh = lane >> 5;
    const bf16_t* LFb = (const bf16_t*)(p.ws + WS_LF); const bf16_t* VT = (const bf16_t*)(p.ws + WS_VT);
    const bf16_t* QH = (const bf16_t*)(p.ws + WS_QH); const bf16_t* GH = (const bf16_t*)(p.ws + WS_GH);
    bf16_t* OB = (bf16_t*)(p.ws + WS_OB);
    const int nw = gridDim.x * 8, gw = blockIdx.x * 8 + wid;
    const int nprompt = (4096 - gw + nw - 1) / nw, nextra = (nw == 2048 && (gw & 15) == 0) ? 1 : (nw == 2048 ? 0 : (128 - gw + nw - 1) / nw);
    for (int ti = 0; ti < nprompt + nextra; ++ti) {
        int it, tt;
        if (ti < nprompt) { const int task = gw + ti * nw; it = task >> 1; tt = task & 1; }
        else { it = 2048 + (nw == 2048 ? (gw >> 4) : gw + (ti - nprompt) * nw); tt = 0; }
        const HItem X = hitem(it);
        const bf16_t* ST = (const bf16_t*)(p.ws + WS_ST) + (size_t)it * 16384;
        const int t = tt * 32 + r;
        const size_t trow = (size_t)(X.tb + t);
        bf16x8 pf[2][2];
        {
            bf16x8 q2f[8];
#pragma unroll
            for (int ks = 0; ks < 8; ++ks) q2f[ks] = *(const bf16x8*)(LFb + trow * 1024 + X.h * 256 + 16 * ks + 8 * hh);
#pragma unroll
            for (int st = 0; st < 2; ++st) {
                if (st <= tt) {
                    f32x16 xs;
#pragma unroll
                    for (int i = 0; i < 16; ++i) xs[i] = 0.f;
                    const bf16_t* kp = LFb + (size_t)(X.tb + st * 32 + r) * 1024 + X.h * 256 + 128 + 8 * hh;
#pragma unroll
                    for (int ks = 0; ks < 8; ++ks) xs = __builtin_amdgcn_mfma_f32_32x32x16_bf16(*(const bf16x8*)(kp + 16 * ks), q2f[ks], xs, 0, 0, 0);
                    float pv[16];
#pragma unroll
                    for (int i = 0; i < 16; ++i) { const int s = st * 32 + (i & 3) + 8 * (i >> 2) + 4 * hh; pv[i] = (s <= t) ? xs[i] : 0.f; }
                    pf[st][0] = pack8(pv); pf[st][1] = pack8(pv + 8);
                }
            }
        }
        bf16x8 q1f[8];
#pragma unroll
        for (int ks = 0; ks < 8; ++ks) q1f[ks] = *(const bf16x8*)(QH + trow * 512 + X.h * 128 + 16 * ks + 8 * hh);
        f32x16 acc[4];
#pragma unroll
        for (int vt = 0; vt < 4; ++vt) {
#pragma unroll
            for (int i = 0; i < 16; ++i) acc[vt][i] = 0.f;
            const bf16_t* sp = ST + (size_t)(vt * 32 + r) * 128 + 8 * hh;
#pragma unroll
            for (int ks = 0; ks < 8; ++ks) acc[vt] = __builtin_amdgcn_mfma_f32_32x32x16_bf16(*(const bf16x8*)(sp + 16 * ks), q1f[ks], acc[vt], 0, 0, 0);
#pragma unroll
            for (int st = 0; st < 2; ++st) {
                if (st <= tt) {
#pragma unroll
                    for (int ks2 = 0; ks2 < 2; ++ks2) {
                        const bf16_t* vp = VT + (size_t)(X.h * 128 + vt * 32 + r) * TPAD + X.tb + st * 32 + 16 * ks2 + 4 * hh;
                        const u32x2 lo = *(const u32x2*)vp, hi = *(const u32x2*)(vp + 8);
                        u32x4v w; w[0] = lo[0]; w[1] = lo[1]; w[2] = hi[0]; w[3] = hi[1];
                        acc[vt] = __builtin_amdgcn_mfma_f32_32x32x16_bf16(__builtin_bit_cast(bf16x8, w), pf[st][ks2], acc[vt], 0, 0, 0);
                    }
                }
            }
        }
        float sq = 0.f;
#pragma unroll
        for (int vt = 0; vt < 4; ++vt)
#pragma unroll
            for (int i = 0; i < 16; ++i) sq += acc[vt][i] * acc[vt][i];
        sq += xor32(sq);
        const float rstd = rsqrtf(sq * (1.0f / 128.0f) + EPSF);
        if (t < X.nt) {
            const float* gh = p.hg_norm_g + l * 512 + X.h * 128;
            f32x4 gv[4][4]; u32x2 ggv[4][4];
#pragma unroll
            for (int vt = 0; vt < 4; ++vt)
#pragma unroll
                for (int ig = 0; ig < 4; ++ig) { const int v0 = vt * 32 + 8 * ig + 4 * hh; gv[vt][ig] = *(const f32x4*)(gh + v0); ggv[vt][ig] = *(const u32x2*)(GH + trow * 512 + X.h * 128 + v0); }
#pragma unroll
            for (int vt = 0; vt < 4; ++vt)
#pragma unroll
                for (int ig = 0; ig < 4; ++ig) {
                    const int v0 = vt * 32 + 8 * ig + 4 * hh;
                    const f32x4 g = gv[vt][ig];
                    const u32x2 gg = ggv[vt][ig];
                    const float s0 = __uint_as_float(gg[0] << 16), s1 = __uint_as_float(gg[0] & 0xffff0000u), s2 = __uint_as_float(gg[1] << 16), s3 = __uint_as_float(gg[1] & 0xffff0000u);
                    u32x2 w; w[0] = pk2(acc[vt][4 * ig] * rstd * g[0] * s0, acc[vt][4 * ig + 1] * rstd * g[1] * s1); w[1] = pk2(acc[vt][4 * ig + 2] * rstd * g[2] * s2, acc[vt][4 * ig + 3] * rstd * g[3] * s3);
                    *(u32x2*)(OB + trow * DM + X.h * 128 + v0) = w;
                }
        }
    }
}

__device__ __forceinline__ int lbid() { int x = blockIdx.x; asm volatile("" : "+s"(x)); return x; }
__device__ __forceinline__ int lgrid() { int x = gridDim.x; asm volatile("" : "+s"(x)); return x; }
__device__ __forceinline__ int lreps(int x) { asm volatile("" : "+s"(x)); return x; }
#ifndef STAG_TICKS
#define STAG_TICKS 400
#endif
__device__ __forceinline__ void stagger() {
    const unsigned g = ((unsigned)lbid() >> 3) & 3u;
    if (STAG_TICKS > 0 && g) { const unsigned long long t0 = __builtin_amdgcn_s_memrealtime(); while (__builtin_amdgcn_s_memrealtime() - t0 < (unsigned long long)(g * STAG_TICKS)) __builtin_amdgcn_s_sleep(8); }
}
#define XB_TMO      128
#define XB_XCNT(j)  (256  + 64 * (j))
#define XB_XSUB(j)  (1280 + 64 * (j))
#define XB_XGEN(j)  (2304 + 64 * (j))
#define XB_TOP      3328
#define XB_TOPGEN   3392
#define XCD_BAR_WORDS 3456
#define XB_SPIN_CAP (1u << 18)
#define LAS __attribute__((address_space(3)))

__device__ __forceinline__ unsigned xb_ld(unsigned* p)              { return __hip_atomic_load(p, __ATOMIC_RELAXED, __HIP_MEMORY_SCOPE_AGENT); }
__device__ __forceinline__ unsigned xb_add(unsigned* p, unsigned v) { return __hip_atomic_fetch_add(p, v, __ATOMIC_RELAXED, __HIP_MEMORY_SCOPE_AGENT); }
__device__ __forceinline__ unsigned xb_xcc_id() { return (unsigned)__builtin_amdgcn_s_getreg((3 << 11) | 20) & 0xFu; }
#define XB_SPIN(cond, bar) do { unsigned _sp = 0; while (cond) { __builtin_amdgcn_s_sleep(1); \
    if ((++_sp & 255u) == 0u) { if (xb_ld(&(bar)[XB_TMO])) break; if (_sp > XB_SPIN_CAP) { atomicAdd(&(bar)[XB_TMO], 1u); break; } } } } while (0)

struct XcdBarrier {
    unsigned* bar; unsigned x;
    volatile LAS unsigned* st;
};

__device__ __forceinline__ XcdBarrier xcd_barrier_post(unsigned* bar, volatile LAS unsigned* st) {
    XcdBarrier b; b.bar = bar; b.x = xb_xcc_id(); b.st = st;
    if (threadIdx.x == 0) (void)xb_add(&bar[XB_XCNT(b.x)], 1u);
    return b;
}
__device__ __forceinline__ void xcd_barrier_complete(unsigned* bar, unsigned x, unsigned& nloc, unsigned& nx) {
    const unsigned G = gridDim.x * gridDim.y * gridDim.z;
    unsigned sum, cnt, mine, sp = 0u;
    for (;;) {
        sum = 0u; cnt = 0u; mine = 0u;
#pragma unroll
        for (unsigned j = 0; j < 16; ++j) { const unsigned c = xb_ld(&bar[XB_XCNT(j)]); sum += c; cnt += (c > 0u) ? 1u : 0u; mine = (j == x) ? c : mine; }
        if (sum == G) break;
        __builtin_amdgcn_s_sleep(1);
        if ((++sp & 255u) == 0u) { if (xb_ld(&bar[XB_TMO])) break; if (sp > XB_SPIN_CAP) { atomicAdd(&bar[XB_TMO], 1u); break; } }
    }
    nloc = mine > 0u ? mine : 1u; nx = cnt > 0u ? cnt : 1u;
}

__device__ __forceinline__ void xcd_barrier(const XcdBarrier& b) {
    asm volatile("s_waitcnt vmcnt(0)" ::: "memory");
    __syncthreads();
    int t0_ = threadIdx.x; asm volatile("" : "+v"(t0_));
    if (t0_ == 0) {
        unsigned* bar = b.bar;
        __builtin_amdgcn_s_waitcnt(0);
        unsigned nloc = b.st[0], nx = b.st[1];
        if (nloc == 0u) { xcd_barrier_complete(bar, b.x, nloc, nx); b.st[0] = nloc; b.st[1] = nx; }
        const unsigned old = xb_add(&bar[XB_XSUB(b.x)], 1u);
        const unsigned gen = old / nloc;
        if (old + 1u == (gen + 1u) * nloc) {
            __builtin_amdgcn_fence(__ATOMIC_RELEASE, "agent");
            asm volatile("s_waitcnt vmcnt(0)" ::: "memory");
            const unsigned og = xb_add(&bar[XB_TOP], 1u);
            const unsigned tg = og / nx;
            if (og + 1u == (tg + 1u) * nx) xb_add(&bar[XB_TOPGEN], 1u);
            else XB_SPIN(xb_ld(&bar[XB_TOPGEN]) == tg, bar);
            __builtin_amdgcn_fence(__ATOMIC_ACQUIRE, "agent");
            xb_add(&bar[XB_XGEN(b.x)], 1u);
            asm volatile("s_waitcnt vmcnt(0)" ::: "memory");
        } else {
            XB_SPIN(xb_ld(&bar[XB_XGEN(b.x)]) == gen, bar);
            __builtin_amdgcn_fence(__ATOMIC_ACQUIRE, "agent");
            asm volatile("s_waitcnt vmcnt(0)" ::: "memory");
        }
    }
    __syncthreads();
}


__device__ __forceinline__ void my_grid_sync(unsigned* bar, unsigned target) {
    int t = threadIdx.x; asm volatile("" : "+v"(t));
    asm volatile("s_waitcnt vmcnt(0)" ::: "memory");
    __syncthreads();
    if (t == 0) {
        __builtin_amdgcn_fence(__ATOMIC_RELEASE, "agent");
        asm volatile("s_waitcnt vmcnt(0)" ::: "memory");
        __hip_atomic_fetch_add(bar, 1u, __ATOMIC_RELAXED, __HIP_MEMORY_SCOPE_AGENT);
        while (__hip_atomic_load(bar, __ATOMIC_RELAXED, __HIP_MEMORY_SCOPE_AGENT) < target) __builtin_amdgcn_s_sleep(1);
        __builtin_amdgcn_fence(__ATOMIC_ACQUIRE, "agent");
        asm volatile("s_waitcnt vmcnt(0)" ::: "memory");
    }
    __syncthreads();
}
#ifndef ONLY
#define ONLY -1
#endif
#ifndef DUPP
#define DUPP -1
#endif
#define REPS(id) _Pragma("nounroll") for (int rep_ = 0, nrep_ = lreps(DUPP == (id) ? 2 : 1); rep_ < nrep_; ++rep_)
__global__ void __launch_bounds__(512, 2) hymba_fwd(Params p_unused) {
    extern __shared__ __attribute__((aligned(16))) unsigned char lds[];
    int lo, hi; { KP kp = kparams(); lo = kp->ph_lo; hi = kp->ph_hi; }
#ifndef SKIPP
#define SKIPP -2
#endif
#define PHID(k) ((k) == 0 ? 0 : (k) == 15 ? 15 : ((k) - 1) % 7 + 1)
#define IN(k) (lo <= (k) && (k) < hi && (ONLY < 0 || ONLY == PHID(k)) && SKIPP != PHID(k))
    unsigned nsync = 0;
    volatile LAS unsigned* xb_st = (volatile LAS unsigned*)((LAS unsigned char*)lds + pg8::STAGE_BYTES + 8 * 2560);
    if (threadIdx.x == 0) { xb_st[0] = 0u; xb_st[1] = 0u; }
    __syncthreads();
    XcdBarrier xbar = xcd_barrier_post((unsigned*)(load_params().ws + WS_BAR), xb_st);
#define SEAM(k) do { if (IN(k) && IN((k) + 1)) { xcd_barrier(xbar); } } while (0)
    if (IN(0)) REPS(0) { const Params p = load_params(); prologue(p, lds); }
    if (lo < 0) cg::this_grid().sync();
    SEAM(0);
    for (int l = 0; l < 2; ++l) {
        const int base = 1 + 7 * l;
        if (IN(base)) REPS(1) {
            const Params p = load_params(); unsigned char* ws = p.ws;
            pg8::Gemm g{(const bf16_t*)(ws + WS_XB), (const bf16_t*)(ws + WS_WIN) + (size_t)l * NIN * DM, T_ALL, NIN, DM, DM};
            pg8::StaticOrder S; S.init(T_ALL, NIN, lgrid(), lbid());
            EpiIn E{l, (PG8_LAS unsigned char*)lds + pg8::STAGE_BYTES, rep_};
            pg8::gemm_phase<EpiIn, pg8::StaticOrder, false>((PG8_LAS unsigned char*)lds, g, S, E, nullptr);
        }
        SEAM(base);
        if (IN(base + 1)) {
            const Params p = load_params(); const int G = gridDim.x, bx = blockIdx.x;
            __syncthreads();
            for (int i = threadIdx.x; i < 8 * 256; i += 512) { const int hh_ = i / 256; int idx = i % 256 - 64; idx = idx < 0 ? 0 : (idx > 256 ? 256 : idx); ((float*)lds)[i] = p.rel_bias[l * 8 * 257 + hh_ * 257 + idx] * 1.4426950408889634f; }
            __syncthreads();
            REPS(8) for (int it = bx; it < 32; it += G) attn_item<true>(p, l, it, lds);
            { const int vb = (G & 7) == 0 ? (bx & 7) * (G >> 3) + (bx >> 3) : bx;
              REPS(9) for (int it = vb; it < 512; it += G) attn_prompt_item(p, l, it, lds); }
            hgrn_passA_phase(p, l, lds);
        }
        SEAM(base + 1);
        if (IN(base + 2)) { const Params p = load_params(); hgrn_scan(p, l); }
        SEAM(base + 2);
        if (IN(base + 3)) REPS(4) { const Params p = load_params(); hgrn_passC_phase(p, l); }
        SEAM(base + 3);
        if (IN(base + 4)) {
            const Params p = load_params(); unsigned char* ws = p.ws;
            __syncthreads();
            pg8::Gemm g{(const bf16_t*)(ws + WS_OB), (const bf16_t*)(ws + WS_WOUT) + (size_t)l * DM * DM, T_ALL, DM, DM, DM};
            pg8::StaticOrder S; S.init(T_ALL, DM, lgrid(), lbid());
            EpiRes<0> E{l, 0};
            pg8::gemm_phase<EpiRes<0>, pg8::StaticOrder, false>((PG8_LAS unsigned char*)lds, g, S, E, nullptr);
        }
        SEAM(base + 4);
        if (IN(base + 5)) REPS(6) {
            const Params p = load_params(); unsigned char* ws = p.ws;
            pg8::Gemm g{(const bf16_t*)(ws + WS_XB), (const bf16_t*)(ws + WS_WUP) + (size_t)l * DFF * DM, T_ALL, DFF, DM, DM};
            pg8::StaticOrder S; S.init(T_ALL, DFF, lgrid(), lbid());
            EpiUp E{l};
            pg8::gemm_phase<EpiUp, pg8::StaticOrder, false>((PG8_LAS unsigned char*)lds, g, S, E, nullptr);
        }
        SEAM(base + 5);
        if (IN(base + 6)) {
            const Params p = load_params(); unsigned char* ws = p.ws;
            {
                pg8::Gemm g{(const bf16_t*)(ws + WS_U), (const bf16_t*)(ws + WS_WDN) + (size_t)l * DM * DFF, T_P, DM, DFF, DFF};
                pg8::StaticOrder S; S.init(T_P, DM, lgrid(), lbid());
                EpiRes<1> E{l, 0};
                    pg8::gemm_phase<EpiRes<1>, pg8::StaticOrder, false>((PG8_LAS unsigned char*)lds, g, S, E, nullptr);
            }
            {
                pg8::Gemm g{(const bf16_t*)(ws + WS_U), (const bf16_t*)(ws + WS_WDN) + (size_t)l * DM * DFF, T_ALL, DM, DFF / 4, DFF};
                SplitOrder S; S.c = lbid();
                EpiSplit E{l};
                pg8::gemm_phase<EpiSplit, SplitOrder, false>((PG8_LAS unsigned char*)lds, g, S, E, nullptr);
            }
        }
        SEAM(base + 6);
    }
#ifdef XSYNC
    for (int i_ = 0; i_ < XSYNC; ++i_) { ++nsync; my_grid_sync((unsigned*)(load_params().ws + WS_BAR), nsync * (unsigned)gridDim.x); }
#endif
    if (IN(15)) { const Params p = load_params(); final_norm(p); }
#undef IN
#undef SEAM
}

extern "C" void kernel_launch(void* const* d_in, const int* in_sizes, int n_in, void* d_out, int out_size, void* d_ws, size_t ws_size, hipStream_t stream) {
    static int grid = 0;
    if (grid == 0) {
        if (n_in != 16 || ws_size < WS_END) { fprintf(stderr, "kernel_launch: need 16 inputs and >= %zu bytes of workspace; got %d, %zu\n", (size_t)WS_END, n_in, ws_size); grid = -1; return; }
        int dev = 0, cus = 0, per_cu = 0;
        (void)hipGetDevice(&dev); (void)hipDeviceGetAttribute(&cus, hipDeviceAttributeMultiprocessorCount, dev);
        if (hipFuncSetAttribute((const void*)hymba_fwd, hipFuncAttributeMaxDynamicSharedMemorySize, LDS_BYTES) != hipSuccess) { fprintf(stderr, "kernel_launch: hipFuncSetAttribute failed\n"); grid = -1; return; }
        if (hipOccupancyMaxActiveBlocksPerMultiprocessor(&per_cu, (const void*)hymba_fwd, 512, LDS_BYTES) != hipSuccess || per_cu < 1) { fprintf(stderr, "kernel_launch: occupancy query says %d\n", per_cu); per_cu = 1; }
        (void)hipGetLastError();
        grid = cus;
    }
    if (grid < 0) return;
    Params p{};
    const float** pp = (const float**)&p;
    for (int i = 0; i < 16; ++i) pp[i] = (const float*)d_in[i];
    p.out = (float*)d_out; p.ws = (unsigned char*)d_ws;
#if MK_ONE_LAUNCH
    (void)hipMemsetAsync((unsigned char*)d_ws + WS_BAR, 0, 16384, stream);
    p.ph_lo = 0; p.ph_hi = 16;
    void* args[] = {&p};
    hipError_t e = hipLaunchCooperativeKernel((const void*)hymba_fwd, dim3(grid), dim3(512), args, LDS_BYTES, stream);
    if (e != hipSuccess) fprintf(stderr, "cooperative launch failed: %s (grid %d)\n", hipGetErrorString(e), grid);
#else
    for (int ph = 0; ph < 16; ++ph) { p.ph_lo = ph; p.ph_hi = ph + 1; hipLaunchKernelGGL(hymba_fwd, dim3(grid), dim3(512), LDS_BYTES, stream, p); }
#endif
}
```
